# Optimizing an MI355X kernel written in HIP

```python
import jax, jax.numpy as jnp
from jax import lax
import numpy as np

D_MODEL = 2048
BATCH = 16
SEQ = 2048
DEPTH = 1

ATTN_HEADS = 8
HEAD_DIM = 128
ATTN_WIDTH = ATTN_HEADS * HEAD_DIM
CONV_WIDTH = D_MODEL - ATTN_WIDTH
IN_WIDTH = 3 * ATTN_WIDTH + 2 * CONV_WIDTH
CONV_KERNEL = 31
MOBA_BLOCK = 256
MOBA_TOPK = 3
Q_CHUNK = 8
ROPE_THETA = 10000.0
D_FF = -(-(8 * D_MODEL) // (3 * 256)) * 256
N_MOD = 6
EPS = 1e-6

kernel_name = "hymba_moba_conformer_adaln_block"


def rms_norm(x, g):
    xf = x.astype(jnp.float32)
    y = xf * lax.rsqrt(jnp.mean(xf * xf, axis=-1, keepdims=True) + EPS)
    return (y * g.astype(jnp.float32)).astype(x.dtype)


def modulate(h, shift, scale):
    return h * (1 + scale[:, None, :]) + shift[:, None, :]


def rope(x, pos):
    half = x.shape[-1] // 2
    inv = ROPE_THETA ** (-jnp.arange(half, dtype=jnp.float32) / half)
    ang = pos[:, None] * inv[None, :]
    cos, sin = jnp.cos(ang), jnp.sin(ang)
    xf = x.astype(jnp.float32)
    x1, x2 = xf[..., :half], xf[..., half:]
    out = jnp.concatenate([x1 * cos - x2 * sin, x2 * cos + x1 * sin], axis=-1)
    return out.astype(x.dtype)


def conv_module(a, b, w, bias, ln_g, ln_b):
    u = a * jax.nn.sigmoid(b)
    y = lax.conv_general_dilated(
        u, w[:, None, :].astype(u.dtype), window_strides=(1,),
        padding=[(CONV_KERNEL - 1, 0)],
        dimension_numbers=("NWC", "WIO", "NWC"),
        feature_group_count=CONV_WIDTH) + bias
    yf = y.astype(jnp.float32)
    mu = jnp.mean(yf, axis=-1, keepdims=True)
    var = jnp.mean(jnp.square(yf - mu), axis=-1, keepdims=True)
    yn = (yf - mu) * lax.rsqrt(var + EPS) * ln_g.astype(jnp.float32) + ln_b.astype(jnp.float32)
    return jax.nn.silu(yn).astype(a.dtype)


def moba_attention(q, k, v):
    B, H, T, D = q.shape
    nb = -(-T // MOBA_BLOCK)
    pad = nb * MOBA_BLOCK - T
    kp = jnp.pad(k, ((0, 0), (0, 0), (0, pad), (0, 0)))
    vp = jnp.pad(v, ((0, 0), (0, 0), (0, pad), (0, 0)))
    k_blocks = kp.reshape(B, H, nb, MOBA_BLOCK, D)
    v_blocks = vp.reshape(B, H, nb, MOBA_BLOCK, D)
    k_mean = jnp.mean(k_blocks.astype(jnp.float32), axis=3)
    topk = min(MOBA_TOPK, nb - 1)
    scale = HEAD_DIM ** -0.5
    neg = jnp.finfo(jnp.float32).min
    b_idx = jnp.arange(B)[:, None, None, None]
    h_idx = jnp.arange(H)[None, :, None, None]

    def chunk(start):
        qc = lax.dynamic_slice_in_dim(q, start, Q_CHUNK, axis=2)
        blk = start // MOBA_BLOCK
        q_pos = start + jnp.arange(Q_CHUNK)
        k_pos = blk * MOBA_BLOCK + jnp.arange(MOBA_BLOCK)
        k_own = lax.dynamic_index_in_dim(k_blocks, blk, axis=2, keepdims=False)
        v_own = lax.dynamic_index_in_dim(v_blocks, blk, axis=2, keepdims=False)
        s_own = jnp.einsum("bhqd,bhkd->bhqk", qc, k_own).astype(jnp.float32) * scale
        s_own = jnp.where(k_pos[None, :] <= q_pos[:, None], s_own, neg)
        if topk > 0:
            gate = jnp.einsum("bhqd,bhnd->bhqn", qc.astype(jnp.float32), k_mean)
            gate = jnp.where(jnp.arange(nb) < blk, gate, -jnp.inf)
            _, sel = lax.top_k(gate, topk)
            k_sel = k_blocks[b_idx, h_idx, sel]
            v_sel = v_blocks[b_idx, h_idx, sel]
            s_sel = jnp.einsum("bhqd,bhqnkd->bhqnk", qc, k_sel).astype(jnp.float32) * scale
            s_sel = jnp.where((sel < blk)[..., None], s_sel, neg)
            s_sel = s_sel.reshape(B, H, Q_CHUNK, topk * MOBA_BLOCK)
            p = jax.nn.softmax(jnp.concatenate([s_own, s_sel], axis=-1), axis=-1)
            p_own = p[..., :MOBA_BLOCK].astype(v.dtype)
            p_sel = p[..., MOBA_BLOCK:].reshape(B, H, Q_CHUNK, topk, MOBA_BLOCK).astype(v.dtype)
            out = (jnp.einsum("bhqk,bhkd->bhqd", p_own, v_own)
                   + jnp.einsum("bhqnk,bhqnkd->bhqd", p_sel, v_sel))
        else:
            p = jax.nn.softmax(s_own, axis=-1).astype(v.dtype)
            out = jnp.einsum("bhqk,bhkd->bhqd", p, v_own)
        return out.transpose(0, 2, 1, 3)

    starts = jnp.arange(0, T, Q_CHUNK, dtype=jnp.int32)
    outs = lax.map(chunk, starts)
    return outs.transpose(1, 0, 2, 3, 4).reshape(B, T, H * D)


def setup_inputs(seed: int = 0) -> dict:
    key = jax.random.key(seed)
    ks = jax.random.split(key, 16)
    f32 = jnp.float32
    n = lambda k, shape, s: jax.random.normal(k, shape, f32) * s
    L = DEPTH
    return {
        "x": n(ks[0], (BATCH, SEQ, D_MODEL), 1.0),
        "c": n(ks[1], (BATCH, D_MODEL), 1.0),
        "w_ada": n(ks[2], (L, D_MODEL, N_MOD * D_MODEL), 0.5 * D_MODEL ** -0.5),
        "b_ada": n(ks[3], (L, N_MOD * D_MODEL), 0.02),
        "g_mix": 1.0 + n(ks[4], (L, D_MODEL), 0.02),
        "w_in": n(ks[5], (L, D_MODEL, IN_WIDTH), D_MODEL ** -0.5),
        "conv_w": n(ks[6], (L, CONV_KERNEL, CONV_WIDTH), CONV_KERNEL ** -0.5),
        "conv_b": n(ks[7], (L, CONV_WIDTH), 0.02),
        "ln_g": 1.0 + n(ks[8], (L, CONV_WIDTH), 0.02),
        "ln_b": n(ks[9], (L, CONV_WIDTH), 0.02),
        "w_out": n(ks[10], (L, D_MODEL, D_MODEL), D_MODEL ** -0.5),
        "g_ffn": 1.0 + n(ks[11], (L, D_MODEL), 0.02),
        "w_gate": n(ks[12], (L, D_MODEL, D_FF), D_MODEL ** -0.5),
        "w_up": n(ks[13], (L, D_MODEL, D_FF), D_MODEL ** -0.5),
        "w_down": n(ks[14], (L, D_FF, D_MODEL), D_FF ** -0.5),
        "g_final": 1.0 + n(ks[15], (D_MODEL,), 0.02),
    }


def reference(x, c, w_ada, b_ada, g_mix, w_in, conv_w, conv_b, ln_g, ln_b,
              w_out, g_ffn, w_gate, w_up, w_down, g_final):
    B, T, _ = x.shape
    pos = jnp.arange(T, dtype=jnp.float32)
    cs = jax.nn.silu(c)
    splits = [ATTN_WIDTH, 2 * ATTN_WIDTH, 3 * ATTN_WIDTH, 3 * ATTN_WIDTH + CONV_WIDTH]
    h = x
    for l in range(DEPTH):
        mod = cs @ w_ada[l] + b_ada[l]
        sh_m, sc_m, gt_m, sh_f, sc_f, gt_f = jnp.split(mod, N_MOD, axis=-1)

        u = modulate(rms_norm(h, g_mix[l]), sh_m, sc_m)
        proj = u @ w_in[l]
        q, k, v, ga, gb = jnp.split(proj, splits, axis=-1)
        to_heads = lambda t: t.reshape(B, T, ATTN_HEADS, HEAD_DIM).transpose(0, 2, 1, 3)
        q = rope(to_heads(q), pos)
        k = rope(to_heads(k), pos)
        v = to_heads(v)
        attn_out = moba_attention(q, k, v)
        conv_out = conv_module(ga, gb, conv_w[l], conv_b[l], ln_g[l], ln_b[l])
        mixed = jnp.concatenate([attn_out, conv_out], axis=-1) @ w_out[l]
        h = h + gt_m[:, None, :] * mixed

        u = modulate(rms_norm(h, g_ffn[l]), sh_f, sc_f)
        ff = (jax.nn.silu(u @ w_gate[l]) * (u @ w_up[l])) @ w_down[l]
        h = h + gt_f[:, None, :] * ff
    return rms_norm(h, g_final)
```

```cpp
#include <hip/hip_runtime.h>
#include <hip/hip_cooperative_groups.h>
#include <cstdio>
#include <cstdint>
namespace cg = cooperative_groups;

constexpr int DM = 2048, BATCH = 16, SEQ = 2048, MROWS = BATCH * SEQ;
constexpr int NH = 8, HD = 128, AW = 1024, CW = 1024, INW = 5120, CK = 31, DFF = 5632, NMODC = 6 * DM;
constexpr float EPS = 1e-6f;

namespace pg8 {
#define PG8_LAS __attribute__((address_space(3)))
typedef unsigned short bf16_t;
typedef short bf16x8 __attribute__((ext_vector_type(8)));
typedef float f32x4 __attribute__((ext_vector_type(4)));
typedef unsigned u32x4 __attribute__((ext_vector_type(4)));
constexpr int BM = 256, BK = 64, HALF = 128, HTB = HALF * BK * 2  , STAGE_BYTES = 8 * HTB, NXCD = 8, WGM = 8;

__host__ __device__ __forceinline__ int lds_byte(int r, int c) { const int st = (r >> 4) * 2 + (c >> 5), rr = r & 15, cc = c & 31, ob = rr * 64 + cc * 2; return st * 1024 + (ob ^ (((ob >> 9) & 1) << 5)); }
__host__ __device__ __forceinline__ void stage_rc(int b, int& R, int& C) { const int st = b / 1024, sb = b % 1024, swz = sb ^ (((sb >> 9) & 1) << 5); R = (st >> 1) * 16 + swz / 64; C = (st & 1) * 32 + (swz % 64) / 2; }
__host__ __device__ __forceinline__ int perm32(int rho) { const int n = rho >> 4, i = rho & 15; return 8 * (i >> 2) + 4 * n + (i & 3); }

struct Unit { int pm, pn; };
struct Gemm { const bf16_t* A; const bf16_t* Bt; int M, N, K; };

struct StaticOrder {
    int nM, nN, nwg, G, c, wgm, rev = 0;
    __host__ __device__ void init(int M, int N, int G_, int c_, int wgm_ = WGM) { nM = M / BM; nN = N / BM; nwg = nM * nN; G = G_; c = c_; wgm = wgm_; }
    __host__ __device__ bool next(int i, Unit& u) const {
        const long L = (long)i * G + c; if (L >= nwg) return false;
        int wgid = (int)L; { const int q = nwg / NXCD, r = nwg % NXCD, xcd = wgid % NXCD, off = wgid / NXCD; wgid = (xcd < r ? xcd * (q + 1) : r * (q + 1) + (xcd - r) * q) + off; }
        const int nig = wgm * nN, gid = wgid / nig, fm = gid * wgm, gsz = (nM - fm) < wgm ? (nM - fm) : wgm;
        u.pm = fm + ((wgid % nig) % gsz); u.pn = (wgid % nig) / gsz; if (rev) u.pm = (u.pm & ~15) | (15 - (u.pm & 15)); return true;
    }
    __device__ __forceinline__ void a_ready(const Unit&) const {}
    __device__ __forceinline__ void done(const Unit&) const {}
};


__device__ __forceinline__ unsigned cvt_pk_bf16(float lo, float hi) { unsigned r; asm volatile("v_cvt_pk_bf16_f32 %0, %1, %2" : "=v"(r) : "v"(lo), "v"(hi)); return r; }
__device__ __forceinline__ float sigmoid_fast(float x) { return __builtin_amdgcn_rcpf(1.0f + __builtin_amdgcn_exp2f(-1.4426950408889634f * x)); }
__device__ __forceinline__ u32x4 pack8(const f32x4 a, const f32x4 b) { u32x4 w; w.x = cvt_pk_bf16(a[0], a[1]); w.y = cvt_pk_bf16(a[2], a[3]); w.z = cvt_pk_bf16(b[0], b[1]); w.w = cvt_pk_bf16(b[2], b[3]); return w; }

struct EpiIn {
    static constexpr bool PERM = true, AFTER_DRAIN = false;
    bf16_t* Q; bf16_t* K; bf16_t* V; bf16_t* GLU; float* KSUM; const float* RC; const float* RS;
    __device__ __forceinline__ void operator()(const f32x4 (&acc)[2][2][4][2], const Unit& u, int wr, int wc, int fr, int fq) const {
        const int b = u.pm >> 3, blk = u.pm & 7, pn = u.pn;
        const int t0 = blk * 256 + wr * 64 + fr;
        if (pn < 8) {
            const int hh = (pn & 3) * 2 + (wc >> 1), dl = (wc & 1) * 32 + fq * 8;
            const bool isk = pn >= 4;
            bf16_t* dst = (isk ? K : Q) + (size_t)(b * NH + hh) * SEQ * HD + dl;
            f32x4 ks[2][2];
#pragma unroll
            for (int i = 0; i < 2; ++i)
#pragma unroll
                for (int j = 0; j < 2; ++j) ks[i][j] = (f32x4){0.f, 0.f, 0.f, 0.f};
#pragma unroll
            for (int ai = 0; ai < 2; ++ai)
#pragma unroll
                for (int m = 0; m < 4; ++m) {
                    const int t = t0 + ai * 128 + m * 16;
                    const f32x4 c0 = *(const f32x4*)(RC + t * 64 + dl), c1 = *(const f32x4*)(RC + t * 64 + dl + 4);
                    const f32x4 s0 = *(const f32x4*)(RS + t * 64 + dl), s1 = *(const f32x4*)(RS + t * 64 + dl + 4);
                    const f32x4 a0 = acc[ai][0][m][0], a1 = acc[ai][0][m][1], b0 = acc[ai][1][m][0], b1 = acc[ai][1][m][1];
                    const f32x4 o10 = a0 * c0 - b0 * s0, o11 = a1 * c1 - b1 * s1, o20 = b0 * c0 + a0 * s0, o21 = b1 * c1 + a1 * s1;
                    *(u32x4*)(dst + (size_t)t * HD) = pack8(o10, o11);
                    *(u32x4*)(dst + (size_t)t * HD + 64) = pack8(o20, o21);
                    ks[0][0] += o10; ks[0][1] += o11; ks[1][0] += o20; ks[1][1] += o21;
                    asm volatile("" ::: "memory");
                }
            if (isk) {
#pragma unroll
                for (int i = 0; i < 2; ++i)
#pragma unroll
                    for (int j = 0; j < 2; ++j)
#pragma unroll
                        for (int e = 0; e < 4; ++e) { float v = ks[i][j][e]; v += __shfl_xor(v, 1); v += __shfl_xor(v, 2); v += __shfl_xor(v, 4); v += __shfl_xor(v, 8); ks[i][j][e] = v; }
                if (fr == 0) { float* kp = KSUM + ((size_t)(b * NH + hh) * 8 + blk) * HD + dl;
#pragma unroll
                    for (int i = 0; i < 2; ++i)
#pragma unroll
                        for (int j = 0; j < 2; ++j)
#pragma unroll
                            for (int e = 0; e < 4; ++e) atomicAdd(kp + i * 64 + j * 4 + e, ks[i][j][e]); }
            }
        } else if (pn < 12) {
#pragma unroll
            for (int bj = 0; bj < 2; ++bj) {
                bf16_t* dst = V + (size_t)(b * NH + (pn - 8) * 2 + bj) * SEQ * HD + wc * 32 + fq * 8;
#pragma unroll
                for (int ai = 0; ai < 2; ++ai)
#pragma unroll
                    for (int m = 0; m < 4; ++m) { const int t = t0 + ai * 128 + m * 16; *(u32x4*)(dst + (size_t)t * HD) = pack8(acc[ai][bj][m][0], acc[ai][bj][m][1]); }
            }
        } else {
            bf16_t* dst = GLU + (size_t)(u.pm * BM + wr * 64 + fr) * CW + (pn - 12) * 128 + wc * 32 + fq * 8;
#pragma unroll
            for (int ai = 0; ai < 2; ++ai)
#pragma unroll
                for (int m = 0; m < 4; ++m) {
                    f32x4 v0 = acc[ai][0][m][0], v1 = acc[ai][0][m][1]; const f32x4 g0 = acc[ai][1][m][0], g1 = acc[ai][1][m][1];
#pragma unroll
                    for (int e = 0; e < 4; ++e) { v0[e] *= sigmoid_fast(g0[e]); v1[e] *= sigmoid_fast(g1[e]); }
                    *(u32x4*)(dst + (size_t)(ai * 128 + m * 16) * CW) = pack8(v0, v1);
                }
        }
    }
};
template <bool BASE_BF16>
struct EpiRes {
    static constexpr bool PERM = true, AFTER_DRAIN = false;
    const void* base; bf16_t* outb; const float* gate;
    __device__ __forceinline__ void operator()(const f32x4 (&acc)[2][2][4][2], const Unit& u, int wr, int wc, int fr, int fq) const {
        const int b = u.pm >> 3, col0 = u.pn * BM + wc * 32 + fq * 8;
        f32x4 gv[2][2];
#pragma unroll
        for (int bj = 0; bj < 2; ++bj)
#pragma unroll
            for (int n = 0; n < 2; ++n) gv[bj][n] = *(const f32x4*)(gate + (size_t)b * NMODC + col0 + bj * HALF + n * 4);
#pragma unroll
        for (int ai = 0; ai < 2; ++ai)
#pragma unroll
            for (int m = 0; m < 4; ++m) { const size_t off = (size_t)(u.pm * BM + ai * HALF + wr * 64 + m * 16 + fr) * DM + col0;
                f32x4 x[2][2];
#pragma unroll
                for (int bj = 0; bj < 2; ++bj) {
                    if (BASE_BF16) { const u32x4 w = *(const u32x4*)((const bf16_t*)base + off + bj * HALF);
                        x[bj][0] = (f32x4){__uint_as_float(w.x << 16), __uint_as_float(w.x & 0xffff0000u), __uint_as_float(w.y << 16), __uint_as_float(w.y & 0xffff0000u)};
                        x[bj][1] = (f32x4){__uint_as_float(w.z << 16), __uint_as_float(w.z & 0xffff0000u), __uint_as_float(w.w << 16), __uint_as_float(w.w & 0xffff0000u)}; }
                    else { x[bj][0] = *(const f32x4*)((const float*)base + off + bj * HALF); x[bj][1] = *(const f32x4*)((const float*)base + off + bj * HALF + 4); } }
#pragma unroll
                for (int bj = 0; bj < 2; ++bj) *(u32x4*)(outb + off + bj * HALF) = pack8(x[bj][0] + gv[bj][0] * acc[ai][bj][m][0], x[bj][1] + gv[bj][1] * acc[ai][bj][m][1]);
                asm volatile("" ::: "memory"); }
    }
};
struct EpiGU {
    static constexpr bool PERM = true, AFTER_DRAIN = false;
    bf16_t* ACT;
    __device__ __forceinline__ void operator()(const f32x4 (&acc)[2][2][4][2], const Unit& u, int wr, int wc, int fr, int fq) const {
        bf16_t* dst = ACT + (size_t)(u.pm * BM + wr * 64 + fr) * DFF + u.pn * 128 + wc * 32 + fq * 8;
#pragma unroll
        for (int ai = 0; ai < 2; ++ai)
#pragma unroll
            for (int m = 0; m < 4; ++m) {
                const f32x4 g0 = acc[ai][0][m][0], g1 = acc[ai][0][m][1];
                f32x4 t0 = g0 * -1.4426950408889634f, t1 = g1 * -1.4426950408889634f;
#pragma unroll
                for (int e = 0; e < 4; ++e) { t0[e] = __builtin_amdgcn_exp2f(t0[e]); t1[e] = __builtin_amdgcn_exp2f(t1[e]); }
                t0 = t0 + 1.0f; t1 = t1 + 1.0f;
#pragma unroll
                for (int e = 0; e < 4; ++e) { t0[e] = __builtin_amdgcn_rcpf(t0[e]); t1[e] = __builtin_amdgcn_rcpf(t1[e]); }
                const f32x4 v0 = (acc[ai][1][m][0] * g0) * t0, v1 = (acc[ai][1][m][1] * g1) * t1;
                __builtin_nontemporal_store(pack8(v0, v1), (u32x4*)(dst + (size_t)(ai * 128 + m * 16) * DFF));
            }
    }
};

template <class Epi, class Sched, bool ALIGN_EPI = false, bool SP2 = false>
__device__ __forceinline__ void gemm_phase(PG8_LAS unsigned char* lds, const Gemm g, const Sched& S, const Epi& E) {
    const int tid = threadIdx.x, wid = __builtin_amdgcn_readfirstlane(tid >> 6), lane = tid & 63, wr = wid >> 2, wc = wid & 3, fr = lane & 15, fq = lane >> 4;
    const int K = g.K, nt = K / BK;
    unsigned voffA[2], voffB[2];
#pragma unroll
    for (int i = 0; i < 2; ++i) { int R, C; stage_rc(tid * 16 + i * 8192, R, C); const int Rb = Epi::PERM ? ((R & ~31) + perm32(R & 31)) : R;
        voffA[i] = (unsigned)(R * K + C) * 2u; voffB[i] = (unsigned)(Rb * K + C) * 2u; }
    const size_t kstep = (size_t)(BK * 2);
    const size_t hstep = (size_t)HALF * K * 2;
    const size_t tstep = 2 * hstep;
    const unsigned ldsw = (unsigned)wid * 1024u;
    const int aoff = lds_byte(wr * 64 + fr, fq * 8), boff = lds_byte(wc * 32 + fr, fq * 8);
#define PG8_SA(b, h) (((b) * 2 + (h)) * HTB)
#define PG8_SB(b, h) ((4 + (b) * 2 + (h)) * HTB)
#define PG8_STAGE(bufoff, gbase, voff) do { _Pragma("unroll") for (int _i = 0; _i < 2; ++_i) \
        __builtin_amdgcn_global_load_lds((const unsigned*)((const char*)(gbase) + (voff)[_i]), (PG8_LAS unsigned*)(lds + (bufoff) + ldsw + _i * 8192), 16, 0, 0); } while (0)
#define PG8_LDA(dst, b, h) do { _Pragma("unroll") for (int m = 0; m < 4; ++m) _Pragma("unroll") for (int k = 0; k < 2; ++k) dst[m][k] = *(const PG8_LAS bf16x8*)(lds + PG8_SA(b, h) + aoff + m * 2048 + k * 1024); } while (0)
#define PG8_LDB(dst, b, h) do { _Pragma("unroll") for (int n = 0; n < 2; ++n) _Pragma("unroll") for (int k = 0; k < 2; ++k) dst[n][k] = *(const PG8_LAS bf16x8*)(lds + PG8_SB(b, h) + boff + n * 2048 + k * 1024); } while (0)
#define PG8_MMA(ai, bj, At, Bt) do { __builtin_amdgcn_s_setprio(1); _Pragma("unroll") for (int m = 0; m < 4; ++m) _Pragma("unroll") for (int n = 0; n < 2; ++n) _Pragma("unroll") for (int k = 0; k < 2; ++k) \
        acc[ai][bj][m][n] = __builtin_amdgcn_mfma_f32_16x16x32_bf16(Bt[n][k], At[m][k], acc[ai][bj][m][n], 0, 0, 0); __builtin_amdgcn_s_setprio(0); } while (0)
#define PG8_WAIT_V(n) asm volatile("s_waitcnt vmcnt(" #n ")" ::: "memory")
#define PG8_WAIT_L(n) asm volatile("s_waitcnt lgkmcnt(" #n ")" ::: "memory")
#define PG8_BAR __builtin_amdgcn_s_barrier()
#define PG8_SCHED __builtin_amdgcn_sched_barrier(0)
    Unit cur, nxt; int ui = 0;
    if (!S.next(0, cur)) return;
    f32x4 acc[2][2][4][2];
#pragma unroll
    for (int a = 0; a < 2; ++a)
#pragma unroll
        for (int b = 0; b < 2; ++b)
#pragma unroll
            for (int m = 0; m < 4; ++m)
#pragma unroll
                for (int n = 0; n < 2; ++n) acc[a][b][m][n] = (f32x4){0.f, 0.f, 0.f, 0.f};
    bf16x8 At[4][2], B0[2][2], B1[2][2];
    const char* cA = (const char*)g.A + (size_t)cur.pm * tstep; const char* cB = (const char*)g.Bt + (size_t)cur.pn * tstep;
    S.a_ready(cur);
    if constexpr (SP2) {
        PG8_STAGE(PG8_SB(0, 0), cB, voffB); PG8_STAGE(PG8_SB(0, 1), cB + hstep, voffB); PG8_STAGE(PG8_SA(0, 0), cA, voffA); PG8_STAGE(PG8_SA(0, 1), cA + hstep, voffA);
        if (wr == 1) PG8_BAR;
        PG8_WAIT_V(2); PG8_BAR;
        PG8_STAGE(PG8_SB(1, 0), cB + kstep, voffB); PG8_STAGE(PG8_SA(1, 0), cA + kstep, voffA); PG8_STAGE(PG8_SB(1, 1), cB + hstep + kstep, voffB);
        PG8_WAIT_V(6); PG8_BAR;
    } else {
        PG8_STAGE(PG8_SB(0, 0), cB, voffB); PG8_STAGE(PG8_SA(0, 0), cA, voffA); PG8_STAGE(PG8_SB(0, 1), cB + hstep, voffB); PG8_STAGE(PG8_SA(0, 1), cA + hstep, voffA);
        if (wr == 1) PG8_BAR;
        PG8_WAIT_V(4); PG8_BAR;
        PG8_STAGE(PG8_SB(1, 0), cB + kstep, voffB); PG8_STAGE(PG8_SA(1, 0), cA + kstep, voffA); PG8_STAGE(PG8_SB(1, 1), cB + hstep + kstep, voffB);
        PG8_WAIT_V(6); PG8_BAR;
    }
    for (;;) {
        const bool has_next = S.next(ui + 1, nxt);
        const char* nA = has_next ? (const char*)g.A + (size_t)nxt.pm * tstep : cA; const char* nB = has_next ? (const char*)g.Bt + (size_t)nxt.pn * tstep : cB;
        for (int t = 0; t < nt; t += 2) {
            const bool last = (t == nt - 2);
            const char* a1 = cA + (size_t)(t + 1) * kstep;
            const char* a2 = last ? nA : cA + (size_t)(t + 2) * kstep; const char* b2 = last ? nB : cB + (size_t)(t + 2) * kstep;
            const char* a3 = a2 + kstep; const char* b3 = b2 + kstep;
            if (last && has_next) S.a_ready(nxt);
            if constexpr (SP2) {
            PG8_LDB(B0, 0, 0); PG8_LDB(B1, 0, 1); PG8_SCHED; PG8_LDA(At, 0, 0); PG8_STAGE(PG8_SA(1, 1), a1 + hstep, voffA);
            PG8_WAIT_V(8); PG8_WAIT_L(0); PG8_BAR; PG8_MMA(0, 0, At, B0); PG8_MMA(0, 1, At, B1); PG8_BAR; PG8_SCHED;
            PG8_LDA(At, 0, 1); PG8_STAGE(PG8_SB(0, 0), b2, voffB); PG8_STAGE(PG8_SB(0, 1), b2 + hstep, voffB); PG8_STAGE(PG8_SA(0, 0), a2, voffA);
            PG8_WAIT_V(8); PG8_WAIT_L(0); PG8_BAR; PG8_MMA(1, 0, At, B0); PG8_MMA(1, 1, At, B1); PG8_BAR; PG8_SCHED;
            PG8_LDB(B0, 1, 0); PG8_LDB(B1, 1, 1); PG8_SCHED; PG8_LDA(At, 1, 0); PG8_STAGE(PG8_SA(0, 1), a2 + hstep, voffA);
            PG8_WAIT_V(8); PG8_WAIT_L(0); PG8_BAR; PG8_MMA(0, 0, At, B0); PG8_MMA(0, 1, At, B1); PG8_BAR; PG8_SCHED;
            PG8_LDA(At, 1, 1); PG8_STAGE(PG8_SB(1, 0), b3, voffB); PG8_STAGE(PG8_SB(1, 1), b3 + hstep, voffB); PG8_STAGE(PG8_SA(1, 0), a3, voffA);
            PG8_WAIT_V(8); PG8_WAIT_L(0); PG8_BAR; PG8_MMA(1, 0, At, B0); PG8_MMA(1, 1, At, B1); PG8_BAR; PG8_SCHED;
            } else {
            PG8_LDB(B0, 0, 0); PG8_SCHED; PG8_LDA(At, 0, 0); PG8_STAGE(PG8_SA(1, 1), a1 + hstep, voffA);
            PG8_WAIT_L(8); PG8_BAR; PG8_WAIT_L(0); PG8_MMA(0, 0, At, B0); PG8_BAR; PG8_SCHED;
            PG8_LDB(B1, 0, 1); PG8_STAGE(PG8_SB(0, 0), b2, voffB);
            PG8_BAR; PG8_WAIT_L(0); PG8_MMA(0, 1, At, B1); PG8_BAR;
            PG8_LDA(At, 0, 1); PG8_STAGE(PG8_SA(0, 0), a2, voffA);
            PG8_BAR; PG8_WAIT_L(0); PG8_MMA(1, 0, At, B0); PG8_BAR; PG8_SCHED;
            PG8_STAGE(PG8_SB(0, 1), b2 + hstep, voffB);
            PG8_WAIT_V(6); PG8_BAR; PG8_MMA(1, 1, At, B1); PG8_BAR;
            PG8_LDB(B0, 1, 0); PG8_SCHED; PG8_LDA(At, 1, 0); PG8_STAGE(PG8_SA(0, 1), a2 + hstep, voffA);
            PG8_WAIT_L(8); PG8_BAR; PG8_WAIT_L(0); PG8_MMA(0, 0, At, B0); PG8_BAR; PG8_SCHED;
            PG8_LDB(B1, 1, 1); PG8_STAGE(PG8_SB(1, 0), b3, voffB);
            PG8_BAR; PG8_WAIT_L(0); PG8_MMA(0, 1, At, B1); PG8_BAR;
            PG8_LDA(At, 1, 1); PG8_STAGE(PG8_SA(1, 0), a3, voffA);
            PG8_BAR; PG8_WAIT_L(0); PG8_MMA(1, 0, At, B0); PG8_BAR; PG8_SCHED;
            PG8_STAGE(PG8_SB(1, 1), b3 + hstep, voffB);
            PG8_WAIT_V(6); PG8_BAR; PG8_MMA(1, 1, At, B1); PG8_BAR;
            }
        }
        if constexpr (ALIGN_EPI) { if (wr == 0) PG8_BAR; }
        if constexpr (!Epi::AFTER_DRAIN) { E(acc, cur, wr, wc, fr, fq); S.done(cur); }
        if (!has_next) break;
#pragma unroll
        for (int a = 0; a < 2; ++a)
#pragma unroll
            for (int b = 0; b < 2; ++b)
#pragma unroll
                for (int m = 0; m < 4; ++m)
#pragma unroll
                    for (int n = 0; n < 2; ++n) acc[a][b][m][n] = (f32x4){0.f, 0.f, 0.f, 0.f};
        cur = nxt; cA = nA; cB = nB; ++ui;
        if constexpr (ALIGN_EPI) { if (wr == 1) PG8_BAR; }
    }
    PG8_WAIT_V(0);
    if constexpr (!ALIGN_EPI) { if (wr == 0) PG8_BAR; }
    PG8_BAR;
    if constexpr (Epi::AFTER_DRAIN) { E.fused(acc, cur, wr, wc, fr, fq, lds, wid, lane); S.done(cur); }
#undef PG8_SA
#undef PG8_SB
#undef PG8_STAGE
#undef PG8_LDA
#undef PG8_LDB
#undef PG8_MMA
#undef PG8_WAIT_V
#undef PG8_WAIT_L
#undef PG8_BAR
#undef PG8_SCHED
}
}
namespace att {
typedef unsigned short bf16;
typedef short bf16x8 __attribute__((ext_vector_type(8)));
typedef short s16x4 __attribute__((ext_vector_type(4)));
typedef float f32x16 __attribute__((ext_vector_type(16)));
typedef float f32x4 __attribute__((ext_vector_type(4)));
typedef unsigned u32x4 __attribute__((ext_vector_type(4)));
template <class A, class Bt> struct same_t { static constexpr bool v = false; };
template <class A> struct same_t<A, A> { static constexpr bool v = true; };
constexpr float SCALE = 0.08838834764831845f;
constexpr float THR = 8.f;
constexpr int NW = 8, QBLK = 32, KVBLK = 64, QB = NW * QBLK, D = 128, LDO = 2048;
constexpr int SHM_V = KVBLK * D * 2, SHM_K = KVBLK * D * 2;
constexpr int LDS_BYTES = 2 * SHM_V + 2 * SHM_K + NW * 64 * 4;
#define KSWZ(row, colB) ((row) * 256 + ((colB) ^ (((row) & 7) << 4)))
#define SBAR() __builtin_amdgcn_sched_barrier(0)
__device__ __forceinline__ int v_st(int k, int c) { const int kk = (k & ~0xC) | ((k & 4) << 1) | ((k & 8) >> 1); return ((kk >> 3) * 4 + (c >> 5)) * 512 + ((kk & 7) * 32 + (c & 31)) * 2; }
__device__ __forceinline__ int v_rd_base(int lane) { return ((lane & 3) << 3) | (((lane >> 2) & 3) << 6) | (((lane >> 4) & 1) << 5) | (((lane >> 5) & 1) << 8); }
constexpr int v_rd_off(int d0, int ks, int half) { return d0 * 512 + ks * 4096 + half * 2048; }
__device__ __forceinline__ int crow(int r, int hi) { return (r & 3) + 8 * (r >> 2) + 4 * hi; }
__device__ __forceinline__ unsigned cvtpk(float lo, float hi) {
    unsigned r; asm volatile("v_cvt_pk_bf16_f32 %0, %1, %2" : "=v"(r) : "v"(lo), "v"(hi)); return r;
}
__device__ __forceinline__ bf16x8 pack8(f32x4 a, f32x4 b) {
    u32x4 w = {cvtpk(a[0], a[1]), cvtpk(a[2], a[3]), cvtpk(b[0], b[1]), cvtpk(b[2], b[3])};
    return *reinterpret_cast<bf16x8*>(&w);
}
template <class T> __device__ __forceinline__ bf16x8 load8(const T* p) {
    if constexpr (same_t<T, float>::v) { return pack8(*(const f32x4*)p, *(const f32x4*)(p + 4)); }
    else { return *reinterpret_cast<const bf16x8*>(p); }
}
__device__ __forceinline__ void mask_tile(f32x16& p0, f32x16& p1, int dq, unsigned W) {
    const float NEG = -__builtin_inff();
#pragma unroll
    for (int r = 0; r < 16; ++r) {
        const int c = (r & 3) + 8 * (r >> 2);
        if ((unsigned)(dq - c) >= W) p0[r] = NEG;
        if ((unsigned)(dq - c - 32) >= W) p1[r] = NEG;
    }
}
__device__ __forceinline__ void partialSM(f32x16& p0, f32x16& p1, float& m_reg, float& mn, float& alpha, const bool keep = true) {
    float pmax = p0[0]; for (int r = 1; r < 16; ++r) pmax = fmaxf(pmax, p0[r]); for (int r = 0; r < 16; ++r) pmax = fmaxf(pmax, p1[r]);
    { auto rr = __builtin_amdgcn_permlane32_swap(__float_as_uint(pmax), __float_as_uint(pmax), false, false);
      pmax = fmaxf(__uint_as_float(rr[0]), __uint_as_float(rr[1])); }
    pmax = keep ? pmax : -__builtin_inff();
    constexpr float C2 = 1.4426950408889634f * SCALE;
    if (__builtin_expect(__all((pmax - m_reg) * SCALE <= THR), 1)) { mn = m_reg; alpha = 1.f; }
    else { mn = fmaxf(m_reg, pmax); alpha = __builtin_amdgcn_exp2f((m_reg - mn) * C2); m_reg = mn; }
    const float mnL = keep ? -mn * C2 : -__builtin_inff();
    p0 = p0 * C2 + mnL; p1 = p1 * C2 + mnL;
    for (int r = 0; r < 16; ++r) p0[r] = __builtin_amdgcn_exp2f(p0[r]);
}
__device__ __forceinline__ void finishSM(f32x16& p0, f32x16& p1, float alpha, float& l_reg, bf16x8& pa0, bf16x8& pa1, bf16x8& pa2, bf16x8& pa3) {
    for (int r = 0; r < 16; ++r) p1[r] = __builtin_amdgcn_exp2f(p1[r]);
    float ps;
    { typedef float f32x8_ __attribute__((ext_vector_type(8))); typedef float f32x2_ __attribute__((ext_vector_type(2)));
      f32x8_ s8 = p0.lo + p0.hi; s8 += p1.lo; s8 += p1.hi; const f32x4 s4 = s8.lo + s8.hi; const f32x2_ s2 = s4.lo + s4.hi; ps = s2.x + s2.y; }
    { auto rr = __builtin_amdgcn_permlane32_swap(__float_as_uint(ps), __float_as_uint(ps), false, false);
      ps = __uint_as_float(rr[0]) + __uint_as_float(rr[1]); }
    l_reg = l_reg * alpha + ps;
#define PK4(P, B_, OUT) do { unsigned a0 = cvtpk(P[B_+0], P[B_+1]), a1 = cvtpk(P[B_+2], P[B_+3]);                          \
        unsigned b0 = cvtpk(P[B_+4], P[B_+5]), b1 = cvtpk(P[B_+6], P[B_+7]);                                             \
        auto r0 = __builtin_amdgcn_permlane32_swap(a0, b0, false, false); auto r1 = __builtin_amdgcn_permlane32_swap(a1, b1, false, false); \
        u32x4 w = {r0[0], r1[0], r0[1], r1[1]}; OUT = *reinterpret_cast<bf16x8*>(&w); } while (0)
    PK4(p0, 0, pa0); PK4(p0, 8, pa1); PK4(p1, 0, pa2); PK4(p1, 8, pa3);
#undef PK4
}
template <int KB, bool SK>
__device__ __forceinline__ void qkt(f32x16& p0, f32x16& p1, const char* K_lds, int r32, int hi, const bf16x8* qr, bool act) {
    if (SK && !act) { const float NEG = -__builtin_inff();
#pragma unroll
        for (int r = 0; r < 16; ++r) { p0[r] = NEG; p1[r] = NEG; } return; }
    p0 = f32x16{}; p1 = f32x16{};
    const char* kb[4];
#pragma unroll
    for (int dd = 0; dd < 4; ++dd) kb[dd] = K_lds + KB * SHM_K + KSWZ(r32, (dd * 16 + hi * 8) * 2);
#pragma unroll
    for (int d0 = 0; d0 < 8; ++d0) { const char* a = kb[d0 & 3] + (d0 >> 2) * 128;
        bf16x8 b0 = *reinterpret_cast<const bf16x8*>(a);
        bf16x8 b1 = *reinterpret_cast<const bf16x8*>(a + 32 * 256);
        p0 = __builtin_amdgcn_mfma_f32_32x32x16_bf16(b0, qr[d0], p0, 0, 0, 0);
        p1 = __builtin_amdgcn_mfma_f32_32x32x16_bf16(b1, qr[d0], p1, 0, 0, 0); }
}
template <int VB, bool SK>
__device__ __forceinline__ void pv_tile(f32x16* o, int vb0, bf16x8 pa0, bf16x8 pa1, bf16x8 pa2, bf16x8 pa3, bool act) {
    if (SK && !act) return;
#define TRRD(dst, off) asm volatile("ds_read_b64_tr_b16 %0, %1 offset:%2" : "=&v"(dst) : "v"(vb0), "i"(off) : "memory")
#define PV_LD(S, d0) do { constexpr int b_ = VB * SHM_V + v_rd_off(d0, 0, 0); \
        TRRD(S##l0, b_); TRRD(S##h0, b_ + 2048); TRRD(S##l1, b_ + 4096); TRRD(S##h1, b_ + 6144); TRRD(S##l2, b_ + 8192); TRRD(S##h2, b_ + 10240); TRRD(S##l3, b_ + 12288); TRRD(S##h3, b_ + 14336); } while (0)
#define PV_MM(S, d0) do { \
        o[d0] = __builtin_amdgcn_mfma_f32_32x32x16_bf16(pa0, (bf16x8){S##l0[0], S##l0[1], S##l0[2], S##l0[3], S##h0[0], S##h0[1], S##h0[2], S##h0[3]}, o[d0], 0, 0, 0);   \
        o[d0] = __builtin_amdgcn_mfma_f32_32x32x16_bf16(pa1, (bf16x8){S##l1[0], S##l1[1], S##l1[2], S##l1[3], S##h1[0], S##h1[1], S##h1[2], S##h1[3]}, o[d0], 0, 0, 0);   \
        o[d0] = __builtin_amdgcn_mfma_f32_32x32x16_bf16(pa2, (bf16x8){S##l2[0], S##l2[1], S##l2[2], S##l2[3], S##h2[0], S##h2[1], S##h2[2], S##h2[3]}, o[d0], 0, 0, 0);   \
        o[d0] = __builtin_amdgcn_mfma_f32_32x32x16_bf16(pa3, (bf16x8){S##l3[0], S##l3[1], S##l3[2], S##l3[3], S##h3[0], S##h3[1], S##h3[2], S##h3[3]}, o[d0], 0, 0, 0); } while (0)
    s16x4 Al0, Al1, Al2, Al3, Ah0, Ah1, Ah2, Ah3, Bl0, Bl1, Bl2, Bl3, Bh0, Bh1, Bh2, Bh3;
    PV_LD(A, 0);
    PV_LD(B, 1); asm volatile("s_waitcnt lgkmcnt(8)" ::: "memory"); SBAR(); PV_MM(A, 0); SBAR();
    PV_LD(A, 2); asm volatile("s_waitcnt lgkmcnt(8)" ::: "memory"); SBAR(); PV_MM(B, 1); SBAR();
    PV_LD(B, 3); asm volatile("s_waitcnt lgkmcnt(8)" ::: "memory"); SBAR(); PV_MM(A, 2); SBAR();
    asm volatile("s_waitcnt lgkmcnt(0)" ::: "memory"); SBAR(); PV_MM(B, 3);
#undef PV_LD
#undef PV_MM
#undef TRRD
}
__device__ __forceinline__ void sel_mask(f32x16& p0, f32x16& p1, bool keep) {
    const float NEG = -__builtin_inff();
#pragma unroll
    for (int r = 0; r < 16; ++r) { p0[r] = keep ? p0[r] : NEG; p1[r] = keep ? p1[r] : NEG; }
}
struct BlockRef { int bh; int blk; };
struct Tensors { const bf16* Q; const bf16* K; bf16* O; const float* KS; };
constexpr size_t VOFF = (size_t)64 * 1024 * 1024 / 2;
constexpr int KS_OFF = LDS_BYTES;
#define BR_Q(r) (T.Q + ((size_t)(r).bh * 2048 + (r).blk * 256) * D)
#define BR_K(r) (T.K + (size_t)(r).bh * 2048 * D)
#define BR_V(r) (T.K + VOFF + (size_t)(r).bh * 2048 * D)
#define BR_O(r) (T.O + ((size_t)((r).bh >> 3) * 2048 + (r).blk * 256) * LDO + ((r).bh & 7) * D)
#define BR_KS(r) (T.KS + (size_t)(r).bh * 8 * D)
struct Seam { bf16x8 qr[8]; bf16x8 st_v0, st_v1, st_k0, st_k1; };
#define ROW(p, k0, rr) ((p) + (size_t)((k0) + (rr)) * D + sc)
#define VMW() asm volatile("s_waitcnt vmcnt(0)" ::: "memory")
#define VMWN(n) asm volatile("s_waitcnt vmcnt(%0)" :: "i"(n) : "memory")
#define SLOAD_H(Kp, Vp, k0) do { unsigned lo__ = loff; asm volatile("" : "+v"(lo__)); const char* kb__ = (const char*)(Kp) + (size_t)(k0) * (D * 2); const char* vb__ = (const char*)(Vp) + (size_t)(k0) * (D * 2);   \
                         S.st_v0 = *(const bf16x8*)(vb__ + lo__); S.st_v1 = *(const bf16x8*)(vb__ + lo__ + 32 * D * 2);              \
                         S.st_k0 = *(const bf16x8*)(kb__ + lo__); S.st_k1 = *(const bf16x8*)(kb__ + lo__ + 32 * D * 2); } while (0)
#define SWRITE_HK(bf) do { *(bf16x8*)(K_lds + (bf) * SHM_K + kws) = S.st_k0; *(bf16x8*)(K_lds + (bf) * SHM_K + kws + 32 * 256) = S.st_k1; } while (0)
#define SWRITE_HV(bf) do { *(bf16x8*)(V_lds + (bf) * SHM_V + vst0) = S.st_v0; *(bf16x8*)(V_lds + (bf) * SHM_V + vst1) = S.st_v1; } while (0)
#define SWRITE_H(bf) do { SWRITE_HV(bf); SWRITE_HK(bf); } while (0)
__device__ __forceinline__ void moba_prime(const Tensors& T, const BlockRef& cur, char* lds, Seam& S) {
    const int tid = threadIdx.x, wid = __builtin_amdgcn_readfirstlane(tid >> 6), lane = tid & 63, r32 = lane & 31, hi = lane >> 5;
    const int sr = tid >> 4, sc = (tid & 15) * 8, kws = KSWZ(sr, sc * 2); char* K_lds = lds + 2 * SHM_V; const unsigned loff = (unsigned)(sr * D + sc) * 2u;
#pragma unroll
    for (int d0 = 0; d0 < 8; ++d0) S.qr[d0] = load8<bf16>(BR_Q(cur) + (size_t)(wid * QBLK + r32) * D + d0 * 16 + hi * 8);
    SLOAD_H(BR_K(cur), BR_V(cur), 0);
    if (tid < 256) { const f32x4 v = *(const f32x4*)(BR_KS(cur) + tid * 4); *(f32x4*)(lds + KS_OFF + tid * 16) = v; }
    VMW(); SWRITE_HK(0);
    __syncthreads();
}
__device__ __forceinline__ void moba_block(const Tensors& T, const BlockRef& cur, const BlockRef& nxt, char* lds, Seam& S) {
    const int tid = threadIdx.x, wid = __builtin_amdgcn_readfirstlane(tid >> 6), lane = tid & 63, r32 = lane & 31, hi = lane >> 5;
    const int blk = cur.blk, P0 = blk * QB;
    const int NT = (P0 + QB) / KVBLK;
    const int qlo = P0 + wid * QBLK, qm = qlo + r32 - 4 * hi;
    char* V_lds = lds; char* K_lds = lds + 2 * SHM_V;
    float* ws = (float*)(lds + 2 * SHM_V + 2 * SHM_K) + wid * 64; float* li_l = ws, * al_l = ws + 32;
    float m_reg = -1e30f, l_reg = 0;
    const int sr = tid >> 4, sc = (tid & 15) * 8, vst0 = v_st(sr, sc), vst1 = v_st(32 + sr, sc), kws = KSWZ(sr, sc * 2); const unsigned loff = (unsigned)(sr * D + sc) * 2u;
    const int vb0 = (int)(uintptr_t)V_lds + v_rd_base(lane);
    const bf16* Kh = BR_K(cur); const bf16* Vh = Kh + VOFF;
    unsigned sel = (1u << blk) - 1u;
#ifndef NO_GATE
    if (blk > 3) {
        float qf[64];
#pragma unroll
        for (int d0 = 0; d0 < 8; ++d0)
#pragma unroll
            for (int e = 0; e < 8; ++e) qf[d0 * 8 + e] = __uint_as_float(((unsigned)(unsigned short)S.qr[d0][e]) << 16);
        float b0 = -__builtin_inff(), b1 = b0, b2 = b0; unsigned i0 = 0u, i1 = 0u, i2 = 0u;
#pragma unroll 1
        for (int n = 0; n < blk; ++n) {
            const float* kp = (const float*)(lds + KS_OFF) + n * 128 + hi * 8;
            float g = 0.f;
#pragma unroll
            for (int d0 = 0; d0 < 8; ++d0) { const f32x4 a = *(const f32x4*)(kp + d0 * 16), b = *(const f32x4*)(kp + d0 * 16 + 4);
                g += (qf[d0 * 8 + 0] * a[0] + qf[d0 * 8 + 1] * a[1]) + (qf[d0 * 8 + 2] * a[2] + qf[d0 * 8 + 3] * a[3]) + (qf[d0 * 8 + 4] * b[0] + qf[d0 * 8 + 5] * b[1]) + (qf[d0 * 8 + 6] * b[2] + qf[d0 * 8 + 7] * b[3]); }
            { auto rr = __builtin_amdgcn_permlane32_swap(__float_as_uint(g), __float_as_uint(g), false, false); g = __uint_as_float(rr[0]) + __uint_as_float(rr[1]); }
            const unsigned bit = 1u << n;
            const bool c0 = g > b0, c1 = g > b1, c2 = g > b2;
            b2 = c1 ? b1 : (c2 ? g : b2); i2 = c1 ? i1 : (c2 ? bit : i2);
            b1 = c0 ? b0 : (c1 ? g : b1); i1 = c0 ? i0 : (c1 ? bit : i1);
            b0 = c0 ? g : b0;             i0 = c0 ? bit : i0;
        }
        sel = i0 | i1 | i2;
    }
#endif
    f32x16 o[4] = {};
#define RESC(a) do { if (__any((a) < 1.f)) { if (hi == 0) al_l[r32] = (a); asm volatile("s_waitcnt lgkmcnt(0)" ::: "memory");              \
                     for (int d_ = 0; d_ < 4; ++d_) for (int r = 0; r < 16; ++r) o[d_][r] *= al_l[crow(r, hi)]; } } while (0)
#define KBASE(t) ((t) * KVBLK)
#define MASKT(P0_, P1_, t) do { const int kb_ = KBASE(t); \
        if (kb_ >= P0) { if (kb_ + KVBLK - 1 > qlo) mask_tile(P0_, P1_, qm - kb_, 0x7fffffffu); } } while (0)
#define KEEPT(t) ((KBASE(t) >= P0) || (((sel >> ((t) >> 2)) & 1u) != 0u))
    constexpr int NQL = 8;
    constexpr bool SK = false;
#define SEAM_K0() do { VMWN(NQL); SWRITE_HK(0); SBAR(); } while (0)
    f32x16 pA0, pA1, pB0, pB1; float mnA, mnB, alA, alB; bf16x8 pa0, pa1, pa2, pa3;
    SWRITE_HV(0); SBAR();
    SLOAD_H(Kh, Vh, KBASE(1));
    SBAR(); qkt<0, SK>(pA0, pA1, K_lds, r32, hi, S.qr, true);
    MASKT(pA0, pA1, 0); partialSM(pA0, pA1, m_reg, mnA, alA, KEEPT(0));
    VMW(); SWRITE_H(1);
    __syncthreads();
#define HALF_STEP(PX0, PX1, mnX, alX, PY0, PY1, alY, t, KB, VB, SB) do {                                                      \
        SBAR(); if ((t) + 1 < NT) { SLOAD_H(Kh, Vh, KBASE((t) + 1)); SBAR(); }                                                \
        qkt<KB, SK>(PX0, PX1, K_lds, r32, hi, S.qr, true);                                                                    \
        finishSM(PY0, PY1, alY, l_reg, pa0, pa1, pa2, pa3); SBAR();                                                           \
        pv_tile<VB, SK>(o, vb0, pa0, pa1, pa2, pa3, true); MASKT(PX0, PX1, (t)); partialSM(PX0, PX1, m_reg, mnX, alX, KEEPT(t));        \
        __syncthreads();                                                                                                      \
        if ((t) + 1 < NT) { VMW(); SWRITE_H(SB); }                                                                            \
        RESC(alX); __syncthreads(); } while (0)
    for (int t = 1; t + 1 < NT; t += 2) {
        HALF_STEP(pB0, pB1, mnB, alB, pA0, pA1, alA, t, 1, 0, 0);
        HALF_STEP(pA0, pA1, mnA, alA, pB0, pB1, alB, t + 1, 0, 1, 1);
    }
    { SBAR(); qkt<1, SK>(pB0, pB1, K_lds, r32, hi, S.qr, true); SBAR(); }
    SLOAD_H(BR_K(nxt), BR_V(nxt), 0); SBAR();
    { unsigned qo__ = (unsigned)((wid * QBLK + r32) * D + hi * 8) * 2u; asm volatile("" : "+v"(qo__)); const char* qb__ = (const char*)BR_Q(nxt) + qo__;
#pragma unroll
      for (int d0 = 0; d0 < 8; ++d0) S.qr[d0] = *(const bf16x8*)(qb__ + d0 * 32); }
    SBAR();
    finishSM(pA0, pA1, alA, l_reg, pa0, pa1, pa2, pa3); SBAR();
    pv_tile<0, SK>(o, vb0, pa0, pa1, pa2, pa3, true);
    { MASKT(pB0, pB1, NT - 1); partialSM(pB0, pB1, m_reg, mnB, alB, KEEPT(NT - 1)); __syncthreads(); RESC(alB);
      finishSM(pB0, pB1, alB, l_reg, pa0, pa1, pa2, pa3); SBAR(); pv_tile<1, SK>(o, vb0, pa0, pa1, pa2, pa3, true); }
    SBAR(); SEAM_K0();
    if (hi == 0) li_l[r32] = l_reg; asm volatile("s_waitcnt lgkmcnt(0)" ::: "memory");
    float rli[16];
#pragma unroll
    for (int r = 0; r < 16; ++r) rli[r] = __builtin_amdgcn_rcpf(li_l[crow(r, hi)]);
    char* Ow = (char*)(BR_O(cur) + (size_t)(wid * QBLK) * LDO);
    unsigned oo__ = (unsigned)(4 * hi * LDO + r32) * 2u; asm volatile("" : "+v"(oo__));
#pragma unroll
    for (int r = 0; r < 16; ++r) { const int orow0 = (r & 3) + 8 * (r >> 2);
#pragma unroll
        for (int d0 = 0; d0 < 4; ++d0) { const float v = o[d0][r] * rli[r];
            const float vn = __shfl_xor(v, 1);
            if ((r32 & 1) == 0) *(unsigned*)(Ow + (size_t)(orow0 * LDO + d0 * 32) * 2 + oo__) = cvtpk(v, vn); } }
    if (tid < 256) { unsigned ko__ = (unsigned)tid * 16u; asm volatile("" : "+v"(ko__)); const f32x4 v = *(const f32x4*)((const char*)BR_KS(nxt) + ko__); *(f32x4*)(lds + KS_OFF + tid * 16) = v; }
    __syncthreads();
#undef RESC
#undef KBASE
#undef MASKT
#undef KEEPT
#undef SEAM_K0
#undef HALF_STEP
}
#undef ROW
#undef BR_Q
#undef BR_K
#undef BR_V
#undef BR_O
#undef BR_KS
#undef VMW
#undef VMWN
#undef SLOAD_H
#undef SWRITE_HK
#undef SWRITE_HV
#undef SWRITE_H
#undef SBAR
#undef KSWZ
}

#define LAS __attribute__((address_space(3)))
typedef unsigned short bf16_t;
typedef float f32x4 __attribute__((ext_vector_type(4)));
typedef float f32x2 __attribute__((ext_vector_type(2)));
typedef unsigned u32x4 __attribute__((ext_vector_type(4)));
typedef unsigned u32x2 __attribute__((ext_vector_type(2)));

constexpr int NTHREADS = 512, NWAVES = 8;
constexpr int RING_BYTES = 131072, LDS_BYTES = RING_BYTES + 4096;
constexpr size_t MiB = 1u << 20;
constexpr size_t WS_MOD = 0, WS_ROPEC = 1 * MiB, WS_ROPES = WS_ROPEC + 512 * 1024, WS_KSUM = 2 * MiB;
constexpr size_t WS_CTL = 3 * MiB;
constexpr size_t WS_WIN = 4 * MiB, WS_WOUT = 24 * MiB, WS_WGU = 32 * MiB, WS_WDN = 76 * MiB;
constexpr size_t WS_U = 98 * MiB, WS_Q = 226 * MiB, WS_K = 290 * MiB, WS_V = 354 * MiB, WS_GLU = 418 * MiB, WS_AC = 482 * MiB;
constexpr size_t WS_ACT = 226 * MiB;
constexpr size_t WS_H1 = 610 * MiB;
constexpr size_t WS_H2 = WS_U;
constexpr size_t WS_END = 738 * MiB;
static_assert(WS_WIN + (size_t)INW * DM * 2 <= WS_WOUT && WS_WOUT + (size_t)DM * DM * 2 <= WS_WGU && WS_WGU + (size_t)2 * DFF * DM * 2 <= WS_WDN && WS_WDN + (size_t)DM * DFF * 2 <= WS_U, "weights map");
static_assert(WS_U + (size_t)MROWS * DM * 2 <= WS_Q && WS_ACT + (size_t)MROWS * DFF * 2 <= WS_END && WS_AC + (size_t)MROWS * DM * 2 <= WS_END, "activation map");

struct Args {
    const float *x, *c, *w_ada, *b_ada, *g_mix, *w_in, *conv_w, *conv_b, *ln_g, *ln_b, *w_out, *g_ffn, *w_gate, *w_up, *w_down, *g_final;
    float* out; unsigned char* ws; int ph_lo, ph_hi;
};

__device__ const double INVREV[64] = {
1.59154943091895346e-01, 1.37822502603982849e-01, 1.19349370211248862e-01, 1.03352296618434064e-01,
8.94994016088910133e-02, 7.75032887553740585e-02, 6.71150830052272551e-02, 5.81192674418762462e-02,
5.03292121044870353e-02, 4.35833021053073297e-02, 3.77415847174197711e-02, 3.26828658723569976e-02,
2.83021958306233987e-02, 2.45086918620698521e-02, 2.12236527647776604e-02, 1.83789261056796667e-02,
1.59154943091895339e-02, 1.37822502603982839e-02, 1.19349370211248862e-02, 1.03352296618434061e-02,
8.94994016088910237e-03, 7.75032887553740550e-03, 6.71150830052272534e-03, 5.81192674418762410e-03,
5.03292121044870370e-03, 4.35833021053073314e-03, 3.77415847174197719e-03, 3.26828658723569932e-03,
2.83021958306233987e-03, 2.45086918620698521e-03, 2.12236527647776622e-03, 1.83789261056796667e-03,
1.59154943091895356e-03, 1.37822502603982878e-03, 1.19349370211248849e-03, 1.03352296618434048e-03,
8.94994016088910237e-04, 7.75032887553740507e-04, 6.71150830052272599e-04, 5.81192674418762388e-04,
5.03292121044870326e-04, 4.35833021053073292e-04, 3.77415847174197741e-04, 3.26828658723569922e-04,
2.83021958306233954e-04, 2.45086918620698543e-04, 2.12236527647776605e-04, 1.83789261056796662e-04,
1.59154943091895351e-04, 1.37822502603982856e-04, 1.19349370211248862e-04, 1.03352296618434061e-04,
8.94994016088910182e-05, 7.75032887553740561e-05, 6.71150830052272545e-05, 5.81192674418762388e-05,
5.03292121044870354e-05, 4.35833021053073225e-05, 3.77415847174197768e-05, 3.26828658723569989e-05,
2.83021958306233961e-05, 2.45086918620698523e-05, 2.12236527647776592e-05, 1.83789261056796682e-05
};

__device__ __forceinline__ unsigned f2bf(float f) { unsigned u = __builtin_bit_cast(unsigned, f); return (u + 0x7fffu + ((u >> 16) & 1u)) >> 16; }
__device__ __forceinline__ unsigned pk2(float lo, float hi) { return f2bf(lo) | (f2bf(hi) << 16); }
__device__ __forceinline__ float wave_sum(float v) {
#pragma unroll
    for (int o = 1; o < 64; o <<= 1) v += __shfl_xor(v, o);
    return v;
}
#define LDS_WAIT() asm volatile("s_waitcnt lgkmcnt(0)" ::: "memory")

__device__ __forceinline__ void transpose_item(const float* __restrict__ W, int N, int col0, int k0, bf16_t* __restrict__ WT, int K, int n0, LAS unsigned* scr, int lane) {
    {
        float v[64];
        const float* wp = W + (size_t)k0 * N + col0 + lane;
#pragma unroll
        for (int i = 0; i < 64; ++i) v[i] = __builtin_nontemporal_load(wp + (size_t)i * N);
#pragma unroll
        for (int i = 0; i < 32; ++i) scr[lane * 36 + i] = pg8::cvt_pk_bf16(v[2 * i], v[2 * i + 1]);
    }
    LDS_WAIT(); asm volatile("" ::: "memory");
#pragma unroll
    for (int j = 0; j < 8; ++j) { const int n = j * 8 + (lane >> 3), ch = lane & 7;
        const u32x4 o = *(const LAS u32x4*)(scr + n * 36 + ch * 4);
        *(u32x4*)(WT + (size_t)(n0 + n) * K + k0 + ch * 8) = o; }
    LDS_WAIT(); asm volatile("" ::: "memory");
}

__device__ __forceinline__ void phase0(const Args& a, LAS unsigned char* lds, int G) {
    const int tid = threadIdx.x, lane = tid & 63, wave = __builtin_amdgcn_readfirstlane(tid >> 6), bx = blockIdx.x;
    float* MOD = (float*)(a.ws + WS_MOD); float* RC = (float*)(a.ws + WS_ROPEC); float* RS = (float*)(a.ws + WS_ROPES); float* KSUM = (float*)(a.ws + WS_KSUM);
    if (bx == 0) { unsigned* ctl = (unsigned*)(a.ws + WS_CTL); for (int i = tid; i < 4096; i += NTHREADS) __hip_atomic_store(ctl + i, 0u, __ATOMIC_RELAXED, __HIP_MEMORY_SCOPE_AGENT); }
    {
        const int gt = bx * NTHREADS + tid, NT = G * NTHREADS;
        for (int i = gt; i < BATCH * NH * 8 * HD; i += NT) KSUM[i] = 0.f;
        for (int i = gt; i < SEQ * 64; i += NT) { const int t = i >> 6, j = i & 63; double rev = (double)t * INVREV[j]; rev -= __builtin_floor(rev); const float fr = (float)rev;
            RC[i] = __builtin_amdgcn_cosf(fr); RS[i] = __builtin_amdgcn_sinf(fr); }
    }
    for (int s = ((G % 8 == 0) ? (bx % 8) * (G / 8) + bx / 8 : bx); s < 256; s += G) {
        const int n0 = s * 48, kbeg = wave * 256, lb = lane & 15, kq = lane >> 4;
        float csr[64];
        { const float* cp = a.c + (size_t)lb * DM + kbeg + kq;
#pragma unroll
          for (int j = 0; j < 64; ++j) { const float cv = cp[4 * j]; csr[j] = cv * __builtin_amdgcn_rcpf(1.0f + __expf(-cv)); } }
        f32x4 acc0 = (f32x4){0.f, 0.f, 0.f, 0.f}, acc1 = acc0, acc2 = acc0;
        const float* wp = a.w_ada + (size_t)(kbeg + kq) * NMODC + n0 + lb;
#pragma unroll
        for (int j = 0; j < 64; ++j) {
            const float w0 = wp[(size_t)(4 * j) * NMODC], w1 = wp[(size_t)(4 * j) * NMODC + 16], w2 = wp[(size_t)(4 * j) * NMODC + 32];
            acc0 = __builtin_amdgcn_mfma_f32_16x16x4f32(csr[j], w0, acc0, 0, 0, 0);
            acc1 = __builtin_amdgcn_mfma_f32_16x16x4f32(csr[j], w1, acc1, 0, 0, 0);
            acc2 = __builtin_amdgcn_mfma_f32_16x16x4f32(csr[j], w2, acc2, 0, 0, 0);
        }
        LAS float* red = (LAS float*)lds;
#pragma unroll
        for (int e = 0; e < 4; ++e) { LAS float* rp = red + (wave * 16 + 4 * kq + e) * 48 + lb; rp[0] = acc0[e]; rp[16] = acc1[e]; rp[32] = acc2[e]; }
        __syncthreads();
        for (int i = tid; i < 16 * 48; i += NTHREADS) { const int b = i / 48, l = i - b * 48; float sum = a.b_ada[n0 + l];
#pragma unroll
            for (int w = 0; w < 8; ++w) sum += red[(w * 16 + b) * 48 + l];
            MOD[(size_t)b * NMODC + n0 + l] = sum; }
        __syncthreads();
    }
}

constexpr int I_IN = 32 * 80, I_OUT = 32 * 32, I_GU = 32 * 176, I_DN = 88 * 32;
__device__ __forceinline__ void weight_copies(const Args& a, LAS unsigned char* lds, int G, const int it_lo, const int it_hi) {
    const int tid = threadIdx.x, lane = tid & 63, wave = __builtin_amdgcn_readfirstlane(tid >> 6), bx = blockIdx.x;
    {
        LAS unsigned* scr = (LAS unsigned*)lds + wave * 2304;
        bf16_t* WIN = (bf16_t*)(a.ws + WS_WIN); bf16_t* WOUT = (bf16_t*)(a.ws + WS_WOUT); bf16_t* WGU = (bf16_t*)(a.ws + WS_WGU); bf16_t* WDN = (bf16_t*)(a.ws + WS_WDN);
        const int gw = bx * NWAVES + wave, NGW = G * NWAVES;
        for (int it = it_lo + gw; it < it_hi; it += NGW) {
            int r = it;
            if (r < I_IN) { const int kb = r / 80, nb = r - kb * 80, n0 = nb * 64; int col0;
                if (n0 < 2048) col0 = (n0 & ~0xC0) | ((n0 & 0x40) << 1) | ((n0 & 0x80) >> 1);
                else if (n0 < 3072) col0 = n0;
                else { const int j = n0 - 3072; col0 = 3072 + ((j >> 7) & 1) * 1024 + (j >> 8) * 128 + (j & 127); }
                transpose_item(a.w_in, INW, col0, kb * 64, WIN, DM, n0, scr, lane); continue; }
            r -= I_IN;
            if (r < I_OUT) { const int kb = r >> 5, nb = r & 31; transpose_item(a.w_out, DM, nb * 64, kb * 64, WOUT, DM, nb * 64, scr, lane); continue; }
            r -= I_OUT;
            if (r < I_GU) { const int kb = r / 176, nb = r - kb * 176, n0 = nb * 64; const int col0 = (n0 >> 8) * 128 + (n0 & 127);
                transpose_item(((n0 >> 7) & 1) ? a.w_up : a.w_gate, DFF, col0, kb * 64, WGU, DM, n0, scr, lane); continue; }
            r -= I_GU;
            { const int kb = r >> 5, nb = r & 31; transpose_item(a.w_down, DM, nb * 64, kb * 64, WDN, DFF, nb * 64, scr, lane); }
        }
    }
}

template <int MODE, bool SRC_BF16>
__device__ __forceinline__ void rows_phase(const void* src, const float* __restrict__ g, const float* __restrict__ sc, const float* __restrict__ sh, bf16_t* __restrict__ dst, float* __restrict__ dstf, int G) {
    const int tid = threadIdx.x, lane = tid & 63, wave = __builtin_amdgcn_readfirstlane(tid >> 6);
    const int gw = blockIdx.x * NWAVES + wave, NGW = G * NWAVES;
    for (int it = gw; it < MROWS / 16; it += NGW) {
        const int row0 = it * 16, b = row0 >> 11;
        f32x4 pa[4][2], pb[4][2];
#pragma unroll
        for (int j = 0; j < 4; ++j)
#pragma unroll
            for (int h = 0; h < 2; ++h) { const int col = 8 * lane + 512 * j + 4 * h; pa[j][h] = *(const f32x4*)(g + col);
                if (MODE == 0) { pa[j][h] = pa[j][h] * (*(const f32x4*)(sc + (size_t)b * NMODC + col) + 1.0f); pb[j][h] = *(const f32x4*)(sh + (size_t)b * NMODC + col); } }
#pragma unroll 2
        for (int r = 0; r < 16; ++r) {
            const size_t roff = (size_t)(row0 + r) * DM + 8 * lane;
            f32x4 v[4][2]; float ss = 0.f;
#pragma unroll
            for (int j = 0; j < 4; ++j) {
                if (SRC_BF16) { const u32x4 w = __builtin_nontemporal_load((const u32x4*)((const bf16_t*)src + roff + 512 * j));
                    v[j][0] = (f32x4){__uint_as_float(w.x << 16), __uint_as_float(w.x & 0xffff0000u), __uint_as_float(w.y << 16), __uint_as_float(w.y & 0xffff0000u)};
                    v[j][1] = (f32x4){__uint_as_float(w.z << 16), __uint_as_float(w.z & 0xffff0000u), __uint_as_float(w.w << 16), __uint_as_float(w.w & 0xffff0000u)}; }
                else { v[j][0] = __builtin_nontemporal_load((const f32x4*)((const float*)src + roff + 512 * j)); v[j][1] = __builtin_nontemporal_load((const f32x4*)((const float*)src + roff + 512 * j + 4)); }
#pragma unroll
                for (int h = 0; h < 2; ++h) ss += (v[j][h][0] * v[j][h][0] + v[j][h][1] * v[j][h][1]) + (v[j][h][2] * v[j][h][2] + v[j][h][3] * v[j][h][3]); }
            const float rstd = 1.0f / sqrtf(wave_sum(ss) * (1.0f / DM) + EPS);
            if (MODE == 0) {
#pragma unroll
                for (int j = 0; j < 4; ++j) { const f32x4 o0 = v[j][0] * rstd * pa[j][0] + pb[j][0], o1 = v[j][1] * rstd * pa[j][1] + pb[j][1];
                    *(u32x4*)(dst + roff + 512 * j) = pg8::pack8(o0, o1); } }
            else {
#pragma unroll
                for (int j = 0; j < 4; ++j) { *(f32x4*)(dstf + roff + 512 * j) = v[j][0] * rstd * pa[j][0]; *(f32x4*)(dstf + roff + 512 * j + 4) = v[j][1] * rstd * pa[j][1]; } }
        }
    }
}

#ifndef P3_REP
#define P3_REP 1
#endif
__device__ __forceinline__ void conv_phase(const Args& a, LAS unsigned char* lds, int G) {
    const int tid = threadIdx.x, lane = tid & 63, wave = __builtin_amdgcn_readfirstlane(tid >> 6);
    const bf16_t* GLU = (const bf16_t*)(a.ws + WS_GLU); bf16_t* AC = (bf16_t*)(a.ws + WS_AC);
    LAS float* red = (LAS float*)lds;
    LAS float* stat = red + 128;
    f32x2 w[CK];
#pragma unroll
    for (int j = 0; j < CK; ++j) w[j] = *(const f32x2*)(a.conv_w + j * CW + 2 * tid);
    const f32x2 bias = *(const f32x2*)(a.conv_b + 2 * tid), lg = *(const f32x2*)(a.ln_g + 2 * tid), lb = *(const f32x2*)(a.ln_b + 2 * tid);
    for (int ctr = blockIdx.x; ctr < P3_REP * (MROWS / 32); ctr += G) { const int ct = ctr % (MROWS / 32);
        const int row0 = ct * 32, t0 = row0 & (SEQ - 1);
        const unsigned* up = (const unsigned*)GLU + (size_t)row0 * (CW / 2) + tid;
        f32x2 x[38];
#pragma unroll
        for (int j = 0; j < 30; ++j) { unsigned p = 0u; if (t0 != 0) p = up[(j - 30) * (CW / 2)]; x[j] = (f32x2){__uint_as_float(p << 16), __uint_as_float(p & 0xffff0000u)}; }
        unsigned nx[8];
#pragma unroll
        for (int o = 0; o < 8; ++o) nx[o] = up[o * (CW / 2)];
        for (int it = 0; it < 4; ++it) {
#pragma unroll
            for (int o = 0; o < 8; ++o) { const unsigned p = nx[o]; x[30 + o] = (f32x2){__uint_as_float(p << 16), __uint_as_float(p & 0xffff0000u)}; }
            if (it < 3) {
#pragma unroll
                for (int o = 0; o < 8; ++o) nx[o] = up[((it + 1) * 8 + o) * (CW / 2)]; }
            f32x2 y[8];
#pragma unroll
            for (int o = 0; o < 8; ++o) y[o] = bias;
#pragma unroll
            for (int j = 0; j < CK; ++j)
#pragma unroll
                for (int o = 0; o < 8; ++o) y[o] += w[j] * x[o + j];
            float sv[16];
#pragma unroll
            for (int o = 0; o < 8; ++o) { sv[2 * o] = y[o][0] + y[o][1]; sv[2 * o + 1] = y[o][0] * y[o][0] + y[o][1] * y[o][1]; }
#pragma unroll
            for (int i = 0; i < 16; ++i) sv[i] = wave_sum(sv[i]);
            if (lane == 0) {
#pragma unroll
                for (int i = 0; i < 16; ++i) red[wave * 16 + i] = sv[i]; }
            __syncthreads();
            if (tid < 8) { float s = 0.f, q = 0.f;
#pragma unroll
                for (int wv = 0; wv < 8; ++wv) { s += red[wv * 16 + 2 * tid]; q += red[wv * 16 + 2 * tid + 1]; }
                const float mean = s * (1.0f / CW), var = q * (1.0f / CW) - mean * mean;
                stat[2 * tid] = mean; stat[2 * tid + 1] = 1.0f / sqrtf(fmaxf(var, 0.f) + EPS); }
            __syncthreads();
#pragma unroll
            for (int o = 0; o < 8; ++o) { const float mean = stat[2 * o], rstd = stat[2 * o + 1];
                const f32x2 yn = (y[o] - mean) * rstd * lg + lb;
                const float o0 = yn[0] * pg8::sigmoid_fast(yn[0]), o1 = yn[1] * pg8::sigmoid_fast(yn[1]);
                *((unsigned*)(AC + (size_t)(row0 + it * 8 + o) * DM + CW) + tid) = pk2(o0, o1); }
#pragma unroll
            for (int j = 0; j < 30; ++j) x[j] = x[j + 8];
        }
    }
}

__device__ __forceinline__ att::BlockRef attn_ref(int vcu, int G, int s) {
    const int Lv = vcu + (s >> 1) * G, y = Lv & 3;
    att::BlockRef r; r.bh = Lv >> 2; r.blk = (s & 1) ? 7 - y : y;
    return r;
}
__device__ __forceinline__ void attn_phase(const Args& a, char* lds, int vcu, int G) {
    static_assert(WS_V - WS_K == 64 * MiB, "att::VOFF");
    int nitems = 0; for (int i = 0; vcu + i * G < BATCH * NH * 4; ++i) ++nitems;
    const int ns = 2 * nitems; if (ns == 0) return;
    att::Tensors T; T.Q = (const bf16_t*)(a.ws + WS_Q); T.K = (const bf16_t*)(a.ws + WS_K); T.O = (bf16_t*)(a.ws + WS_AC); T.KS = (const float*)(a.ws + WS_KSUM);
    att::Seam S; att::BlockRef cur = attn_ref(vcu, G, 0);
    att::moba_prime(T, cur, lds, S);
#ifndef P3_REP
#define P3_REP 1
#endif
    for (int s = 0; s < ns * P3_REP; ++s) {
        const att::BlockRef nxt = (s + 1 < ns * P3_REP) ? attn_ref(vcu, G, (s + 1) % ns) : cur;
        att::moba_block(T, cur, nxt, lds, S);
        cur = nxt;
    }
}

#define RLX_AGENT __ATOMIC_RELAXED, __HIP_MEMORY_SCOPE_AGENT
#define XB_TMO      128
#define XB_XCNT(j)  (256  + 64 * (j))
#define XB_XSUB(j)  (1280 + 64 * (j))
#define XB_XGEN(j)  (2304 + 64 * (j))
#define XB_TOP      3328
#define XB_TOPGEN   3392
#define XCD_BAR_WORDS 3456
#define XB_SPIN_CAP (1u << 18)

__device__ __forceinline__ unsigned xb_ld(unsigned* p)              { return __hip_atomic_load(p, __ATOMIC_RELAXED, __HIP_MEMORY_SCOPE_AGENT); }
__device__ __forceinline__ unsigned xb_add(unsigned* p, unsigned v) { return __hip_atomic_fetch_add(p, v, __ATOMIC_RELAXED, __HIP_MEMORY_SCOPE_AGENT); }
__device__ __forceinline__ unsigned xb_xcc_id() { return (unsigned)__builtin_amdgcn_s_getreg((3 << 11) | 20) & 0xFu; }
#define XB_SPIN(cond, bar) do { unsigned _sp = 0; while (cond) { __builtin_amdgcn_s_sleep(1); \
    if ((++_sp & 255u) == 0u) { if (xb_ld(&(bar)[XB_TMO])) break; if (_sp > XB_SPIN_CAP) { atomicAdd(&(bar)[XB_TMO], 1u); break; } } } } while (0)

struct XcdBarrier {
    unsigned* bar; unsigned x;
    volatile LAS unsigned* st;
};

__device__ __forceinline__ XcdBarrier xcd_barrier_post(unsigned* bar, volatile LAS unsigned* st) {
    XcdBarrier b; b.bar = bar; b.x = xb_xcc_id(); b.st = st;
    if (threadIdx.x == 0) (void)xb_add(&bar[XB_XCNT(b.x)], 1u);
    return b;
}
__device__ __forceinline__ void xcd_barrier_complete(unsigned* bar, unsigned x, unsigned& nloc, unsigned& nx) {
    const unsigned G = gridDim.x * gridDim.y * gridDim.z;
    unsigned sum, cnt, mine, sp = 0u;
    for (;;) {
        sum = 0u; cnt = 0u; mine = 0u;
#pragma unroll
        for (unsigned j = 0; j < 16; ++j) { const unsigned c = xb_ld(&bar[XB_XCNT(j)]); sum += c; cnt += (c > 0u) ? 1u : 0u; mine = (j == x) ? c : mine; }
        if (sum == G) break;
        __builtin_amdgcn_s_sleep(1);
        if ((++sp & 255u) == 0u) { if (xb_ld(&bar[XB_TMO])) break; if (sp > XB_SPIN_CAP) { atomicAdd(&bar[XB_TMO], 1u); break; } }
    }
    nloc = mine > 0u ? mine : 1u; nx = cnt > 0u ? cnt : 1u;
}

__device__ __forceinline__ void xcd_barrier(const XcdBarrier& b) {
    asm volatile("s_waitcnt vmcnt(0)" ::: "memory");
    __syncthreads();
    if (threadIdx.x == 0) {
        unsigned* bar = b.bar;
        __builtin_amdgcn_s_waitcnt(0);
        unsigned nloc = b.st[0], nx = b.st[1];
        if (nloc == 0u) { xcd_barrier_complete(bar, b.x, nloc, nx); b.st[0] = nloc; b.st[1] = nx; }
        const unsigned old = xb_add(&bar[XB_XSUB(b.x)], 1u);
        const unsigned gen = old / nloc;
        if (old + 1u == (gen + 1u) * nloc) {
            __builtin_amdgcn_fence(__ATOMIC_RELEASE, "agent");
            asm volatile("s_waitcnt vmcnt(0)" ::: "memory");
            const unsigned og = xb_add(&bar[XB_TOP], 1u);
            const unsigned tg = og / nx;
            if (og + 1u == (tg + 1u) * nx) xb_add(&bar[XB_TOPGEN], 1u);
            else XB_SPIN(xb_ld(&bar[XB_TOPGEN]) == tg, bar);
            __builtin_amdgcn_fence(__ATOMIC_ACQUIRE, "agent");
            xb_add(&bar[XB_XGEN(b.x)], 1u);
            asm volatile("s_waitcnt vmcnt(0)" ::: "memory");
        } else {
            XB_SPIN(xb_ld(&bar[XB_XGEN(b.x)]) == gen, bar);
            __builtin_amdgcn_fence(__ATOMIC_ACQUIRE, "agent");
            asm volatile("s_waitcnt vmcnt(0)" ::: "memory");
        }
    }
    __syncthreads();
}

typedef const __attribute__((address_space(4))) Args* ArgsP;
__device__ __forceinline__ Args load_args() {
#if defined(__HIP_DEVICE_COMPILE__)
    ArgsP p = (ArgsP)__builtin_amdgcn_kernarg_segment_ptr(); asm volatile("" : "+s"(p)); return *p;
#else
    return Args{};
#endif
}
__global__ void __launch_bounds__(NTHREADS, 2) mega_fwd(Args a_unused) {
    extern __shared__ __attribute__((aligned(16))) unsigned char lds_raw[];
    LAS unsigned char* lds = (LAS unsigned char*)lds_raw;
    const int G = gridDim.x, bx = blockIdx.x;
    const int vcu = (G % 8 == 0) ? (bx % 8) * (G / 8) + bx / 8 : bx;
    cg::grid_group grid = cg::this_grid();
    volatile LAS unsigned* bst = (volatile LAS unsigned*)(lds + RING_BYTES);
    if (threadIdx.x < 4) bst[threadIdx.x] = 0u;
    __syncthreads();
    XcdBarrier bar; bar.bar = nullptr; bar.x = 0; bar.st = bst;
    const int lo = a_unused.ph_lo, hi = a_unused.ph_hi;
#ifndef PH_MASK
#define PH_MASK 0x1ff
#endif
#ifndef REP_MASK
#define REP_MASK 0
#endif
#define IN(k) (((PH_MASK >> (k)) & 1) && lo <= (k) && (k) < hi)
#define REP(k) for (int rep_ = 0; rep_ < 1 + ((REP_MASK >> (k)) & 1); ++rep_)
#define SEAM(k) do { if (IN(k) && IN((k) + 1)) { if ((k) == 0) { grid.sync(); bar = xcd_barrier_post((unsigned*)(load_args().ws + WS_CTL), bst); } else xcd_barrier(bar); } } while (0)
    if (IN(0)) REP(0) { const Args a = load_args(); phase0(a, lds, G); } SEAM(0);
    if (IN(1)) REP(1) { const Args a = load_args(); float* MOD = (float*)(a.ws + WS_MOD); rows_phase<0, false>(a.x, a.g_mix, MOD + DM, MOD, (bf16_t*)(a.ws + WS_U), nullptr, G); weight_copies(a, lds, G, 0, I_IN + I_OUT); } SEAM(1);
    if (IN(2)) REP(2) { const Args a = load_args();
        pg8::Gemm g{(const bf16_t*)(a.ws + WS_U), (const bf16_t*)(a.ws + WS_WIN), MROWS, INW, DM}; pg8::StaticOrder S; S.init(MROWS, INW, G, bx, 2);
        pg8::EpiIn E{(bf16_t*)(a.ws + WS_Q), (bf16_t*)(a.ws + WS_K), (bf16_t*)(a.ws + WS_V), (bf16_t*)(a.ws + WS_GLU), (float*)(a.ws + WS_KSUM), (const float*)(a.ws + WS_ROPEC), (const float*)(a.ws + WS_ROPES)};
        pg8::gemm_phase<pg8::EpiIn, pg8::StaticOrder, true, true>(lds, g, S, E);
    } SEAM(2);
    if (IN(3)) REP(3) {
#ifndef NO_ATTN
        { const Args a = load_args(); attn_phase(a, (char*)lds_raw, vcu, G); } __syncthreads();
#endif
#ifndef NO_CONV
        { const Args a = load_args(); conv_phase(a, lds, G); } __syncthreads();
#endif
    } SEAM(3);
    if (IN(4)) REP(4) { const Args a = load_args();
        pg8::Gemm g{(const bf16_t*)(a.ws + WS_AC), (const bf16_t*)(a.ws + WS_WOUT), MROWS, DM, DM}; pg8::StaticOrder S; S.init(MROWS, DM, G, bx, 4);
        pg8::EpiRes<false> E{a.x, (bf16_t*)(a.ws + WS_H1), (const float*)(a.ws + WS_MOD) + 2 * DM};
        pg8::gemm_phase<pg8::EpiRes<false>, pg8::StaticOrder, true, true>(lds, g, S, E);
    } SEAM(4);
    if (IN(5)) REP(5) { const Args a = load_args(); float* MOD = (float*)(a.ws + WS_MOD); weight_copies(a, lds, G, I_IN + I_OUT, I_IN + I_OUT + I_GU + I_DN); rows_phase<0, true>(a.ws + WS_H1, a.g_ffn, MOD + 4 * DM, MOD + 3 * DM, (bf16_t*)(a.ws + WS_U), nullptr, G); } SEAM(5);
    if (IN(6)) REP(6) { const Args a = load_args();
        pg8::Gemm g{(const bf16_t*)(a.ws + WS_U), (const bf16_t*)(a.ws + WS_WGU), MROWS, 2 * DFF, DM}; pg8::StaticOrder S; S.init(MROWS, 2 * DFF, G, bx, 2);
        pg8::EpiGU E{(bf16_t*)(a.ws + WS_ACT)};
        pg8::gemm_phase<pg8::EpiGU, pg8::StaticOrder, true, true>(lds, g, S, E);
    } SEAM(6);
    if (IN(7)) REP(7) { const Args a = load_args();
        pg8::Gemm g{(const bf16_t*)(a.ws + WS_ACT), (const bf16_t*)(a.ws + WS_WDN), MROWS, DM, DFF}; pg8::StaticOrder S; S.init(MROWS, DM, G, bx, 4); S.rev = 1;
        pg8::EpiRes<true> E{a.ws + WS_H1, (bf16_t*)(a.ws + WS_H2), (const float*)(a.ws + WS_MOD) + 5 * DM};
        pg8::gemm_phase<pg8::EpiRes<true>, pg8::StaticOrder, true, true>(lds, g, S, E);
    } SEAM(7);
    if (IN(8)) REP(8) { const Args a = load_args(); rows_phase<1, true>(a.ws + WS_H2, a.g_final, nullptr, nullptr, nullptr, a.out, G); }
#undef IN
#undef SEAM
}

#ifndef MK_N_LAUNCHES
#define MK_N_LAUNCHES 1
#endif
extern "C" void kernel_launch(void* const* d_in, const int* in_sizes, int n_in, void* d_out, int out_size, void* d_ws, size_t ws_size, hipStream_t stream) {
    static int grid = 0;
    if (grid == 0) {
        if (n_in != 16 || in_sizes[0] != MROWS * DM || out_size != MROWS * DM || ws_size < WS_END) {
            fprintf(stderr, "kernel_launch: unexpected shapes (n_in %d, in0 %d, out %d, ws %zu); nothing launched\n", n_in, n_in > 0 ? in_sizes[0] : -1, out_size, ws_size); grid = -1; return; }
        int dev = 0, cus = 0, per_cu = 0;
        (void)hipGetDevice(&dev); (void)hipDeviceGetAttribute(&cus, hipDeviceAttributeMultiprocessorCount, dev);
        if (hipFuncSetAttribute((const void*)mega_fwd, hipFuncAttributeMaxDynamicSharedMemorySize, LDS_BYTES) != hipSuccess) { fprintf(stderr, "kernel_launch: hipFuncSetAttribute failed\n"); grid = -1; return; }
        if (hipOccupancyMaxActiveBlocksPerMultiprocessor(&per_cu, (const void*)mega_fwd, NTHREADS, LDS_BYTES) != hipSuccess || per_cu < 1) { fprintf(stderr, "kernel_launch: occupancy query gave %d\n", per_cu); per_cu = 1; }
        (void)hipGetLastError();
        if (cus <= 0) cus = 256;
        grid = cus * per_cu;
        fprintf(stderr, "kernel_launch: grid %d (cus %d x %d)\n", grid, cus, per_cu);
    }
    if (grid < 0) return;
    Args a{};
    a.x = (const float*)d_in[0]; a.c = (const float*)d_in[1]; a.w_ada = (const float*)d_in[2]; a.b_ada = (const float*)d_in[3]; a.g_mix = (const float*)d_in[4];
    a.w_in = (const float*)d_in[5]; a.conv_w = (const float*)d_in[6]; a.conv_b = (const float*)d_in[7]; a.ln_g = (const float*)d_in[8]; a.ln_b = (const float*)d_in[9];
    a.w_out = (const float*)d_in[10]; a.g_ffn = (const float*)d_in[11]; a.w_gate = (const float*)d_in[12]; a.w_up = (const float*)d_in[13]; a.w_down = (const float*)d_in[14]; a.g_final = (const float*)d_in[15];
    a.out = (float*)d_out; a.ws = (unsigned char*)d_ws;
    constexpr int NPH = 9;
    if (MK_N_LAUNCHES == 1) {
        a.ph_lo = 0; a.ph_hi = NPH;
        void* args[] = {&a};
        const hipError_t e = hipLaunchCooperativeKernel((const void*)mega_fwd, dim3(grid), dim3(NTHREADS), args, LDS_BYTES, stream);
        if (e != hipSuccess) fprintf(stderr, "kernel_launch: cooperative launch failed: %s (grid %d)\n", hipGetErrorString(e), grid);
    } else {
        for (int p = 0; p < NPH; ++p) { a.ph_lo = p; a.ph_hi = p + 1; hipLaunchKernelGGL(mega_fwd, dim3(grid), dim3(NTHREADS), LDS_BYTES, stream, a); }
    }
}
```

```cpp
#include <hip/hip_runtime.h>
#include <hip/hip_cooperative_groups.h>
#include <cstdio>
#include <cstdint>
namespace cg = cooperative_groups;

constexpr int DM = 2048, BATCH = 16, SEQ = 2048, MROWS = BATCH * SEQ;
constexpr int NH = 8, HD = 128, AW = 1024, CW = 1024, INW = 5120, CK = 31, DFF = 5632, NMODC = 6 * DM;
constexpr float EPS = 1e-6f;

namespace pg8 {
#define PG8_LAS __attribute__((address_space(3)))
typedef unsigned short bf16_t;
typedef short bf16x8 __attribute__((ext_vector_type(8)));
typedef float f32x4 __attribute__((ext_vector_type(4)));
typedef unsigned u32x4 __attribute__((ext_vector_type(4)));
constexpr int BM = 256, BK = 64, HALF = 128, HTB = HALF * BK * 2  , STAGE_BYTES = 8 * HTB, NXCD = 8, WGM = 8;

__host__ __device__ __forceinline__ int lds_byte(int r, int c) { const int st = (r >> 4) * 2 + (c >> 5), rr = r & 15, cc = c & 31, ob = rr * 64 + cc * 2; return st * 1024 + (ob ^ (((ob >> 9) & 1) << 5)); }
__host__ __device__ __forceinline__ void stage_rc(int b, int& R, int& C) { const int st = b / 1024, sb = b % 1024, swz = sb ^ (((sb >> 9) & 1) << 5); R = (st >> 1) * 16 + swz / 64; C = (st & 1) * 32 + (swz % 64) / 2; }
__host__ __device__ __forceinline__ int perm32(int rho) { const int n = rho >> 4, i = rho & 15; return 8 * (i >> 2) + 4 * n + (i & 3); }

struct Unit { int pm, pn; };
struct Gemm { const bf16_t* A; const bf16_t* Bt; int M, N, K; };

struct StaticOrder {
    int nM, nN, nwg, G, c, wgm, rot = 0, rev = 0;
    __host__ __device__ void init(int M, int N, int G_, int c_, int wgm_ = WGM) { nM = M / BM; nN = N / BM; nwg = nM * nN; G = G_; c = c_; wgm = wgm_; }
    __host__ __device__ bool next(int i, Unit& u) const {
        const long L = (long)i * G + c; if (L >= nwg) return false;
        int wgid = (int)L; { const int q = nwg / NXCD, r = nwg % NXCD, xcd = wgid % NXCD, off = wgid / NXCD; wgid = (xcd < r ? xcd * (q + 1) : r * (q + 1) + (xcd - r) * q) + off; }
        const int nig = wgm * nN, gid = wgid / nig, fm = gid * wgm, gsz = (nM - fm) < wgm ? (nM - fm) : wgm;
        u.pm = fm + ((wgid % nig) % gsz); u.pn = (wgid % nig) / gsz; if (rev) u.pm = (u.pm & ~15) | (15 - (u.pm & 15)); if (rot) { u.pn += rot * (int)(L % NXCD); if (u.pn >= nN) u.pn -= nN; } return true;
    }
    __device__ __forceinline__ void a_ready(const Unit&) const {}
    __device__ __forceinline__ void done(const Unit&) const {}
};


__device__ __forceinline__ unsigned cvt_pk_bf16(float lo, float hi) { unsigned r; asm volatile("v_cvt_pk_bf16_f32 %0, %1, %2" : "=v"(r) : "v"(lo), "v"(hi)); return r; }
__device__ __forceinline__ float sigmoid_fast(float x) { return __builtin_amdgcn_rcpf(1.0f + __builtin_amdgcn_exp2f(-1.4426950408889634f * x)); }
__device__ __forceinline__ u32x4 pack8(const f32x4 a, const f32x4 b) { u32x4 w; w.x = cvt_pk_bf16(a[0], a[1]); w.y = cvt_pk_bf16(a[2], a[3]); w.z = cvt_pk_bf16(b[0], b[1]); w.w = cvt_pk_bf16(b[2], b[3]); return w; }

struct EpiIn {
    static constexpr bool PERM = true, AFTER_DRAIN = false;
    bf16_t* Q; bf16_t* K; bf16_t* V; bf16_t* GLU; float* KSUM; const float* RC; const float* RS;
    __device__ __forceinline__ void operator()(const f32x4 (&acc)[2][2][4][2], const Unit& u, int wr, int wc, int fr, int fq) const {
        const int b = u.pm >> 3, blk = u.pm & 7, pn = u.pn;
        const int t0 = blk * 256 + wr * 64 + fr;
        if (pn < 8) {
            const int hh = (pn & 3) * 2 + (wc >> 1), dl = (wc & 1) * 32 + fq * 8;
            const bool isk = pn >= 4;
            bf16_t* dst = (isk ? K : Q) + (size_t)(b * NH + hh) * SEQ * HD + dl;
            f32x4 ks[2][2];
#pragma unroll
            for (int i = 0; i < 2; ++i)
#pragma unroll
                for (int j = 0; j < 2; ++j) ks[i][j] = (f32x4){0.f, 0.f, 0.f, 0.f};
#pragma unroll
            for (int ai = 0; ai < 2; ++ai)
#pragma unroll
                for (int m = 0; m < 4; ++m) {
                    const int t = t0 + ai * 128 + m * 16;
                    const f32x4 c0 = *(const f32x4*)(RC + t * 64 + dl), c1 = *(const f32x4*)(RC + t * 64 + dl + 4);
                    const f32x4 s0 = *(const f32x4*)(RS + t * 64 + dl), s1 = *(const f32x4*)(RS + t * 64 + dl + 4);
                    const f32x4 a0 = acc[ai][0][m][0], a1 = acc[ai][0][m][1], b0 = acc[ai][1][m][0], b1 = acc[ai][1][m][1];
                    const f32x4 o10 = a0 * c0 - b0 * s0, o11 = a1 * c1 - b1 * s1, o20 = b0 * c0 + a0 * s0, o21 = b1 * c1 + a1 * s1;
                    *(u32x4*)(dst + (size_t)t * HD) = pack8(o10, o11);
                    *(u32x4*)(dst + (size_t)t * HD + 64) = pack8(o20, o21);
                    ks[0][0] += o10; ks[0][1] += o11; ks[1][0] += o20; ks[1][1] += o21;
                    asm volatile("" ::: "memory");
                }
            if (isk) {
#pragma unroll
                for (int i = 0; i < 2; ++i)
#pragma unroll
                    for (int j = 0; j < 2; ++j)
#pragma unroll
                        for (int e = 0; e < 4; ++e) { float v = ks[i][j][e]; v += __shfl_xor(v, 1); v += __shfl_xor(v, 2); v += __shfl_xor(v, 4); v += __shfl_xor(v, 8); ks[i][j][e] = v; }
                if (fr == 0) { float* kp = KSUM + ((size_t)(b * NH + hh) * 8 + blk) * HD + dl;
#pragma unroll
                    for (int i = 0; i < 2; ++i)
#pragma unroll
                        for (int j = 0; j < 2; ++j)
#pragma unroll
                            for (int e = 0; e < 4; ++e) atomicAdd(kp + i * 64 + j * 4 + e, ks[i][j][e]); }
            }
        } else if (pn < 12) {
#pragma unroll
            for (int bj = 0; bj < 2; ++bj) {
                bf16_t* dst = V + (size_t)(b * NH + (pn - 8) * 2 + bj) * SEQ * HD + wc * 32 + fq * 8;
#pragma unroll
                for (int ai = 0; ai < 2; ++ai)
#pragma unroll
                    for (int m = 0; m < 4; ++m) { const int t = t0 + ai * 128 + m * 16; *(u32x4*)(dst + (size_t)t * HD) = pack8(acc[ai][bj][m][0], acc[ai][bj][m][1]); }
            }
        } else {
            bf16_t* dst = GLU + (size_t)(u.pm * BM + wr * 64 + fr) * CW + (pn - 12) * 128 + wc * 32 + fq * 8;
#pragma unroll
            for (int ai = 0; ai < 2; ++ai)
#pragma unroll
                for (int m = 0; m < 4; ++m) {
                    f32x4 v0 = acc[ai][0][m][0], v1 = acc[ai][0][m][1]; const f32x4 g0 = acc[ai][1][m][0], g1 = acc[ai][1][m][1];
#pragma unroll
                    for (int e = 0; e < 4; ++e) { v0[e] *= sigmoid_fast(g0[e]); v1[e] *= sigmoid_fast(g1[e]); }
                    *(u32x4*)(dst + (size_t)(ai * 128 + m * 16) * CW) = pack8(v0, v1);
                }
        }
    }
};
template <bool BASE_BF16>
struct EpiRes {
    static constexpr bool PERM = true, AFTER_DRAIN = false;
    const void* base; bf16_t* outb; const float* gate;
    __device__ __forceinline__ void operator()(const f32x4 (&acc)[2][2][4][2], const Unit& u, int wr, int wc, int fr, int fq) const {
        const int b = u.pm >> 3, col0 = u.pn * BM + wc * 32 + fq * 8;
        f32x4 gv[2][2];
#pragma unroll
        for (int bj = 0; bj < 2; ++bj)
#pragma unroll
            for (int n = 0; n < 2; ++n) gv[bj][n] = *(const f32x4*)(gate + (size_t)b * NMODC + col0 + bj * HALF + n * 4);
#pragma unroll
        for (int ai = 0; ai < 2; ++ai)
#pragma unroll
            for (int m = 0; m < 4; ++m) { const size_t off = (size_t)(u.pm * BM + ai * HALF + wr * 64 + m * 16 + fr) * DM + col0;
                f32x4 x[2][2];
#pragma unroll
                for (int bj = 0; bj < 2; ++bj) {
                    if (BASE_BF16) { const u32x4 w = *(const u32x4*)((const bf16_t*)base + off + bj * HALF);
                        x[bj][0] = (f32x4){__uint_as_float(w.x << 16), __uint_as_float(w.x & 0xffff0000u), __uint_as_float(w.y << 16), __uint_as_float(w.y & 0xffff0000u)};
                        x[bj][1] = (f32x4){__uint_as_float(w.z << 16), __uint_as_float(w.z & 0xffff0000u), __uint_as_float(w.w << 16), __uint_as_float(w.w & 0xffff0000u)}; }
                    else { x[bj][0] = *(const f32x4*)((const float*)base + off + bj * HALF); x[bj][1] = *(const f32x4*)((const float*)base + off + bj * HALF + 4); } }
#pragma unroll
                for (int bj = 0; bj < 2; ++bj) *(u32x4*)(outb + off + bj * HALF) = pack8(x[bj][0] + gv[bj][0] * acc[ai][bj][m][0], x[bj][1] + gv[bj][1] * acc[ai][bj][m][1]);
                asm volatile("" ::: "memory"); }
    }
};
struct EpiGU {
    static constexpr bool PERM = true, AFTER_DRAIN = false;
    bf16_t* ACT;
    __device__ __forceinline__ void operator()(const f32x4 (&acc)[2][2][4][2], const Unit& u, int wr, int wc, int fr, int fq) const {
        bf16_t* dst = ACT + (size_t)(u.pm * BM + wr * 64 + fr) * DFF + u.pn * 128 + wc * 32 + fq * 8;
#pragma unroll
        for (int ai = 0; ai < 2; ++ai)
#pragma unroll
            for (int m = 0; m < 4; ++m) {
                const f32x4 g0 = acc[ai][0][m][0], g1 = acc[ai][0][m][1];
                f32x4 t0 = g0 * -1.4426950408889634f, t1 = g1 * -1.4426950408889634f;
#pragma unroll
                for (int e = 0; e < 4; ++e) { t0[e] = __builtin_amdgcn_exp2f(t0[e]); t1[e] = __builtin_amdgcn_exp2f(t1[e]); }
                t0 = t0 + 1.0f; t1 = t1 + 1.0f;
#pragma unroll
                for (int e = 0; e < 4; ++e) { t0[e] = __builtin_amdgcn_rcpf(t0[e]); t1[e] = __builtin_amdgcn_rcpf(t1[e]); }
                const f32x4 v0 = (acc[ai][1][m][0] * g0) * t0, v1 = (acc[ai][1][m][1] * g1) * t1;
                __builtin_nontemporal_store(pack8(v0, v1), (u32x4*)(dst + (size_t)(ai * 128 + m * 16) * DFF));
            }
    }
};

template <class Epi, class Sched, bool ALIGN_EPI = false, bool SP2 = false>
__device__ __forceinline__ void gemm_phase(PG8_LAS unsigned char* lds, const Gemm g, const Sched& S, const Epi& E) {
    const int tid = threadIdx.x, wid = __builtin_amdgcn_readfirstlane(tid >> 6), lane = tid & 63, wr = wid >> 2, wc = wid & 3, fr = lane & 15, fq = lane >> 4;
    const int K = g.K, nt = K / BK;
    unsigned voffA[2], voffB[2];
#pragma unroll
    for (int i = 0; i < 2; ++i) { int R, C; stage_rc(tid * 16 + i * 8192, R, C); const int Rb = Epi::PERM ? ((R & ~31) + perm32(R & 31)) : R;
        voffA[i] = (unsigned)(R * K + C) * 2u; voffB[i] = (unsigned)(Rb * K + C) * 2u; }
    const size_t kstep = (size_t)(BK * 2);
    const size_t hstep = (size_t)HALF * K * 2;
    const size_t tstep = 2 * hstep;
    const unsigned ldsw = (unsigned)wid * 1024u;
    const int aoff = lds_byte(wr * 64 + fr, fq * 8), boff = lds_byte(wc * 32 + fr, fq * 8);
#define PG8_SA(b, h) (((b) * 2 + (h)) * HTB)
#define PG8_SB(b, h) ((4 + (b) * 2 + (h)) * HTB)
#define PG8_STAGE(bufoff, gbase, voff) do { _Pragma("unroll") for (int _i = 0; _i < 2; ++_i) \
        __builtin_amdgcn_global_load_lds((const unsigned*)((const char*)(gbase) + (voff)[_i]), (PG8_LAS unsigned*)(lds + (bufoff) + ldsw + _i * 8192), 16, 0, 0); } while (0)
#define PG8_LDA(dst, b, h) do { _Pragma("unroll") for (int m = 0; m < 4; ++m) _Pragma("unroll") for (int k = 0; k < 2; ++k) dst[m][k] = *(const PG8_LAS bf16x8*)(lds + PG8_SA(b, h) + aoff + m * 2048 + k * 1024); } while (0)
#define PG8_LDB(dst, b, h) do { _Pragma("unroll") for (int n = 0; n < 2; ++n) _Pragma("unroll") for (int k = 0; k < 2; ++k) dst[n][k] = *(const PG8_LAS bf16x8*)(lds + PG8_SB(b, h) + boff + n * 2048 + k * 1024); } while (0)
#define PG8_MMA(ai, bj, At, Bt) do { __builtin_amdgcn_s_setprio(1); _Pragma("unroll") for (int m = 0; m < 4; ++m) _Pragma("unroll") for (int n = 0; n < 2; ++n) _Pragma("unroll") for (int k = 0; k < 2; ++k) \
        acc[ai][bj][m][n] = __builtin_amdgcn_mfma_f32_16x16x32_bf16(Bt[n][k], At[m][k], acc[ai][bj][m][n], 0, 0, 0); __builtin_amdgcn_s_setprio(0); } while (0)
#define PG8_WAIT_V(n) asm volatile("s_waitcnt vmcnt(" #n ")" ::: "memory")
#define PG8_WAIT_L(n) asm volatile("s_waitcnt lgkmcnt(" #n ")" ::: "memory")
#define PG8_BAR __builtin_amdgcn_s_barrier()
#define PG8_SCHED __builtin_amdgcn_sched_barrier(0)
    Unit cur, nxt; int ui = 0;
    if (!S.next(0, cur)) return;
    f32x4 acc[2][2][4][2];
#pragma unroll
    for (int a = 0; a < 2; ++a)
#pragma unroll
        for (int b = 0; b < 2; ++b)
#pragma unroll
            for (int m = 0; m < 4; ++m)
#pragma unroll
                for (int n = 0; n < 2; ++n) acc[a][b][m][n] = (f32x4){0.f, 0.f, 0.f, 0.f};
    bf16x8 At[4][2], B0[2][2], B1[2][2];
    const char* cA = (const char*)g.A + (size_t)cur.pm * tstep; const char* cB = (const char*)g.Bt + (size_t)cur.pn * tstep;
    S.a_ready(cur);
    if constexpr (SP2) {
        PG8_STAGE(PG8_SB(0, 0), cB, voffB); PG8_STAGE(PG8_SB(0, 1), cB + hstep, voffB); PG8_STAGE(PG8_SA(0, 0), cA, voffA); PG8_STAGE(PG8_SA(0, 1), cA + hstep, voffA);
        if (wr == 1) PG8_BAR;
        PG8_WAIT_V(2); PG8_BAR;
        PG8_STAGE(PG8_SB(1, 0), cB + kstep, voffB); PG8_STAGE(PG8_SA(1, 0), cA + kstep, voffA); PG8_STAGE(PG8_SB(1, 1), cB + hstep + kstep, voffB);
        PG8_WAIT_V(6); PG8_BAR;
    } else {
        PG8_STAGE(PG8_SB(0, 0), cB, voffB); PG8_STAGE(PG8_SA(0, 0), cA, voffA); PG8_STAGE(PG8_SB(0, 1), cB + hstep, voffB); PG8_STAGE(PG8_SA(0, 1), cA + hstep, voffA);
        if (wr == 1) PG8_BAR;
        PG8_WAIT_V(4); PG8_BAR;
        PG8_STAGE(PG8_SB(1, 0), cB + kstep, voffB); PG8_STAGE(PG8_SA(1, 0), cA + kstep, voffA); PG8_STAGE(PG8_SB(1, 1), cB + hstep + kstep, voffB);
        PG8_WAIT_V(6); PG8_BAR;
    }
    for (;;) {
        const bool has_next = S.next(ui + 1, nxt);
        const char* nA = has_next ? (const char*)g.A + (size_t)nxt.pm * tstep : cA; const char* nB = has_next ? (const char*)g.Bt + (size_t)nxt.pn * tstep : cB;
        for (int t = 0; t < nt; t += 2) {
            const bool last = (t == nt - 2);
            const char* a1 = cA + (size_t)(t + 1) * kstep;
            const char* a2 = last ? nA : cA + (size_t)(t + 2) * kstep; const char* b2 = last ? nB : cB + (size_t)(t + 2) * kstep;
            const char* a3 = a2 + kstep; const char* b3 = b2 + kstep;
            if (last && has_next) S.a_ready(nxt);
            if constexpr (SP2) {
            PG8_LDB(B0, 0, 0); PG8_LDB(B1, 0, 1); PG8_SCHED; PG8_LDA(At, 0, 0); PG8_STAGE(PG8_SA(1, 1), a1 + hstep, voffA);
            PG8_WAIT_V(8); PG8_WAIT_L(0); PG8_BAR; PG8_MMA(0, 0, At, B0); PG8_MMA(0, 1, At, B1); PG8_BAR; PG8_SCHED;
            PG8_LDA(At, 0, 1); PG8_STAGE(PG8_SB(0, 0), b2, voffB); PG8_STAGE(PG8_SB(0, 1), b2 + hstep, voffB); PG8_STAGE(PG8_SA(0, 0), a2, voffA);
            PG8_WAIT_V(8); PG8_WAIT_L(0); PG8_BAR; PG8_MMA(1, 0, At, B0); PG8_MMA(1, 1, At, B1); PG8_BAR; PG8_SCHED;
            PG8_LDB(B0, 1, 0); PG8_LDB(B1, 1, 1); PG8_SCHED; PG8_LDA(At, 1, 0); PG8_STAGE(PG8_SA(0, 1), a2 + hstep, voffA);
            PG8_WAIT_V(8); PG8_WAIT_L(0); PG8_BAR; PG8_MMA(0, 0, At, B0); PG8_MMA(0, 1, At, B1); PG8_BAR; PG8_SCHED;
            PG8_LDA(At, 1, 1); PG8_STAGE(PG8_SB(1, 0), b3, voffB); PG8_STAGE(PG8_SB(1, 1), b3 + hstep, voffB); PG8_STAGE(PG8_SA(1, 0), a3, voffA);
            PG8_WAIT_V(8); PG8_WAIT_L(0); PG8_BAR; PG8_MMA(1, 0, At, B0); PG8_MMA(1, 1, At, B1); PG8_BAR; PG8_SCHED;
            } else {
            PG8_LDB(B0, 0, 0); PG8_SCHED; PG8_LDA(At, 0, 0); PG8_STAGE(PG8_SA(1, 1), a1 + hstep, voffA);
            PG8_WAIT_L(8); PG8_BAR; PG8_WAIT_L(0); PG8_MMA(0, 0, At, B0); PG8_BAR; PG8_SCHED;
            PG8_LDB(B1, 0, 1); PG8_STAGE(PG8_SB(0, 0), b2, voffB);
            PG8_BAR; PG8_WAIT_L(0); PG8_MMA(0, 1, At, B1); PG8_BAR;
            PG8_LDA(At, 0, 1); PG8_STAGE(PG8_SA(0, 0), a2, voffA);
            PG8_BAR; PG8_WAIT_L(0); PG8_MMA(1, 0, At, B0); PG8_BAR; PG8_SCHED;
            PG8_STAGE(PG8_SB(0, 1), b2 + hstep, voffB);
            PG8_WAIT_V(6); PG8_BAR; PG8_MMA(1, 1, At, B1); PG8_BAR;
            PG8_LDB(B0, 1, 0); PG8_SCHED; PG8_LDA(At, 1, 0); PG8_STAGE(PG8_SA(0, 1), a2 + hstep, voffA);
            PG8_WAIT_L(8); PG8_BAR; PG8_WAIT_L(0); PG8_MMA(0, 0, At, B0); PG8_BAR; PG8_SCHED;
            PG8_LDB(B1, 1, 1); PG8_STAGE(PG8_SB(1, 0), b3, voffB);
            PG8_BAR; PG8_WAIT_L(0); PG8_MMA(0, 1, At, B1); PG8_BAR;
            PG8_LDA(At, 1, 1); PG8_STAGE(PG8_SA(1, 0), a3, voffA);
            PG8_BAR; PG8_WAIT_L(0); PG8_MMA(1, 0, At, B0); PG8_BAR; PG8_SCHED;
            PG8_STAGE(PG8_SB(1, 1), b3 + hstep, voffB);
            PG8_WAIT_V(6); PG8_BAR; PG8_MMA(1, 1, At, B1); PG8_BAR;
            }
        }
        if constexpr (ALIGN_EPI) { if (wr == 0) PG8_BAR; }
        if constexpr (!Epi::AFTER_DRAIN) { E(acc, cur, wr, wc, fr, fq); S.done(cur); }
        if (!has_next) break;
#pragma unroll
        for (int a = 0; a < 2; ++a)
#pragma unroll
            for (int b = 0; b < 2; ++b)
#pragma unroll
                for (int m = 0; m < 4; ++m)
#pragma unroll
                    for (int n = 0; n < 2; ++n) acc[a][b][m][n] = (f32x4){0.f, 0.f, 0.f, 0.f};
        cur = nxt; cA = nA; cB = nB; ++ui;
        if constexpr (ALIGN_EPI) { if (wr == 1) PG8_BAR; }
    }
    PG8_WAIT_V(0);
    if constexpr (!ALIGN_EPI) { if (wr == 0) PG8_BAR; }
    PG8_BAR;
    if constexpr (Epi::AFTER_DRAIN) { E.fused(acc, cur, wr, wc, fr, fq, lds, wid, lane); S.done(cur); }
#undef PG8_SA
#undef PG8_SB
#undef PG8_STAGE
#undef PG8_LDA
#undef PG8_LDB
#undef PG8_MMA
#undef PG8_WAIT_V
#undef PG8_WAIT_L
#undef PG8_BAR
#undef PG8_SCHED
}
}
namespace att {
typedef unsigned short bf16;
typedef short bf16x8 __attribute__((ext_vector_type(8)));
typedef short s16x4 __attribute__((ext_vector_type(4)));
typedef float f32x16 __attribute__((ext_vector_type(16)));
typedef float f32x4 __attribute__((ext_vector_type(4)));
typedef unsigned u32x4 __attribute__((ext_vector_type(4)));
template <class A, class Bt> struct same_t { static constexpr bool v = false; };
template <class A> struct same_t<A, A> { static constexpr bool v = true; };
constexpr float SCALE = 0.08838834764831845f;
constexpr float THR = 8.f;
constexpr int NW = 8, QBLK = 32, KVBLK = 64, QB = NW * QBLK, D = 128, LDO = 2048;
constexpr int SHM_V = KVBLK * D * 2, SHM_K = KVBLK * D * 2;
constexpr int LDS_BYTES = 2 * SHM_V + 2 * SHM_K + NW * 64 * 4;
#define KSWZ(row, colB) ((row) * 256 + ((colB) ^ (((row) & 7) << 4)))
#define SBAR() __builtin_amdgcn_sched_barrier(0)
__device__ __forceinline__ int v_st(int k, int c) { const int kk = (k & ~0xC) | ((k & 4) << 1) | ((k & 8) >> 1); return ((kk >> 3) * 4 + (c >> 5)) * 512 + ((kk & 7) * 32 + (c & 31)) * 2; }
__device__ __forceinline__ int v_rd_base(int lane) { return ((lane & 3) << 3) | (((lane >> 2) & 3) << 6) | (((lane >> 4) & 1) << 5) | (((lane >> 5) & 1) << 8); }
constexpr int v_rd_off(int d0, int ks, int half) { return d0 * 512 + ks * 4096 + half * 2048; }
__device__ __forceinline__ int crow(int r, int hi) { return (r & 3) + 8 * (r >> 2) + 4 * hi; }
__device__ __forceinline__ unsigned cvtpk(float lo, float hi) {
    unsigned r; asm volatile("v_cvt_pk_bf16_f32 %0, %1, %2" : "=v"(r) : "v"(lo), "v"(hi)); return r;
}
__device__ __forceinline__ bf16x8 pack8(f32x4 a, f32x4 b) {
    u32x4 w = {cvtpk(a[0], a[1]), cvtpk(a[2], a[3]), cvtpk(b[0], b[1]), cvtpk(b[2], b[3])};
    return *reinterpret_cast<bf16x8*>(&w);
}
template <class T> __device__ __forceinline__ bf16x8 load8(const T* p) {
    if constexpr (same_t<T, float>::v) { return pack8(*(const f32x4*)p, *(const f32x4*)(p + 4)); }
    else { return *reinterpret_cast<const bf16x8*>(p); }
}
__device__ __forceinline__ void mask_tile(f32x16& p0, f32x16& p1, int dq, unsigned W) {
    const float NEG = -__builtin_inff();
#pragma unroll
    for (int r = 0; r < 16; ++r) {
        const int c = (r & 3) + 8 * (r >> 2);
        if ((unsigned)(dq - c) >= W) p0[r] = NEG;
        if ((unsigned)(dq - c - 32) >= W) p1[r] = NEG;
    }
}
__device__ __forceinline__ void partialSM(f32x16& p0, f32x16& p1, float& m_reg, float& mn, float& alpha, const bool keep = true) {
    float pmax = p0[0]; for (int r = 1; r < 16; ++r) pmax = fmaxf(pmax, p0[r]); for (int r = 0; r < 16; ++r) pmax = fmaxf(pmax, p1[r]);
    { auto rr = __builtin_amdgcn_permlane32_swap(__float_as_uint(pmax), __float_as_uint(pmax), false, false);
      pmax = fmaxf(__uint_as_float(rr[0]), __uint_as_float(rr[1])); }
    pmax = keep ? pmax : -__builtin_inff();
    constexpr float C2 = 1.4426950408889634f * SCALE;
    if (__builtin_expect(__all((pmax - m_reg) * SCALE <= THR), 1)) { mn = m_reg; alpha = 1.f; }
    else { mn = fmaxf(m_reg, pmax); alpha = __builtin_amdgcn_exp2f((m_reg - mn) * C2); m_reg = mn; }
    const float mnL = keep ? -mn * C2 : -__builtin_inff();
    p0 = p0 * C2 + mnL; p1 = p1 * C2 + mnL;
    for (int r = 0; r < 16; ++r) p0[r] = __builtin_amdgcn_exp2f(p0[r]);
}
__device__ __forceinline__ void finishSM(f32x16& p0, f32x16& p1, float alpha, float& l_reg, bf16x8& pa0, bf16x8& pa1, bf16x8& pa2, bf16x8& pa3) {
    for (int r = 0; r < 16; ++r) p1[r] = __builtin_amdgcn_exp2f(p1[r]);
    float ps;
    { typedef float f32x8_ __attribute__((ext_vector_type(8))); typedef float f32x2_ __attribute__((ext_vector_type(2)));
      f32x8_ s8 = p0.lo + p0.hi; s8 += p1.lo; s8 += p1.hi; const f32x4 s4 = s8.lo + s8.hi; const f32x2_ s2 = s4.lo + s4.hi; ps = s2.x + s2.y; }
    { auto rr = __builtin_amdgcn_permlane32_swap(__float_as_uint(ps), __float_as_uint(ps), false, false);
      ps = __uint_as_float(rr[0]) + __uint_as_float(rr[1]); }
    l_reg = l_reg * alpha + ps;
#define PK4(P, B_, OUT) do { unsigned a0 = cvtpk(P[B_+0], P[B_+1]), a1 = cvtpk(P[B_+2], P[B_+3]);                          \
        unsigned b0 = cvtpk(P[B_+4], P[B_+5]), b1 = cvtpk(P[B_+6], P[B_+7]);                                             \
        auto r0 = __builtin_amdgcn_permlane32_swap(a0, b0, false, false); auto r1 = __builtin_amdgcn_permlane32_swap(a1, b1, false, false); \
        u32x4 w = {r0[0], r1[0], r0[1], r1[1]}; OUT = *reinterpret_cast<bf16x8*>(&w); } while (0)
    PK4(p0, 0, pa0); PK4(p0, 8, pa1); PK4(p1, 0, pa2); PK4(p1, 8, pa3);
#undef PK4
}
template <int KB, bool SK>
__device__ __forceinline__ void qkt(f32x16& p0, f32x16& p1, const char* K_lds, int r32, int hi, const bf16x8* qr, bool act) {
    if (SK && !act) { const float NEG = -__builtin_inff();
#pragma unroll
        for (int r = 0; r < 16; ++r) { p0[r] = NEG; p1[r] = NEG; } return; }
    p0 = f32x16{}; p1 = f32x16{};
    const char* kb[4];
#pragma unroll
    for (int dd = 0; dd < 4; ++dd) kb[dd] = K_lds + KB * SHM_K + KSWZ(r32, (dd * 16 + hi * 8) * 2);
#pragma unroll
    for (int d0 = 0; d0 < 8; ++d0) { const char* a = kb[d0 & 3] + (d0 >> 2) * 128;
        bf16x8 b0 = *reinterpret_cast<const bf16x8*>(a);
        bf16x8 b1 = *reinterpret_cast<const bf16x8*>(a + 32 * 256);
        p0 = __builtin_amdgcn_mfma_f32_32x32x16_bf16(b0, qr[d0], p0, 0, 0, 0);
        p1 = __builtin_amdgcn_mfma_f32_32x32x16_bf16(b1, qr[d0], p1, 0, 0, 0); }
}
template <int VB, bool SK>
__device__ __forceinline__ void pv_tile(f32x16* o, int vb0, bf16x8 pa0, bf16x8 pa1, bf16x8 pa2, bf16x8 pa3, bool act) {
    if (SK && !act) return;
#define TRRD(dst, off) asm volatile("ds_read_b64_tr_b16 %0, %1 offset:%2" : "=&v"(dst) : "v"(vb0), "i"(off) : "memory")
#define PV_LD(S, d0) do { constexpr int b_ = VB * SHM_V + v_rd_off(d0, 0, 0); \
        TRRD(S##l0, b_); TRRD(S##h0, b_ + 2048); TRRD(S##l1, b_ + 4096); TRRD(S##h1, b_ + 6144); TRRD(S##l2, b_ + 8192); TRRD(S##h2, b_ + 10240); TRRD(S##l3, b_ + 12288); TRRD(S##h3, b_ + 14336); } while (0)
#define PV_MM(S, d0) do { \
        o[d0] = __builtin_amdgcn_mfma_f32_32x32x16_bf16(pa0, (bf16x8){S##l0[0], S##l0[1], S##l0[2], S##l0[3], S##h0[0], S##h0[1], S##h0[2], S##h0[3]}, o[d0], 0, 0, 0);   \
        o[d0] = __builtin_amdgcn_mfma_f32_32x32x16_bf16(pa1, (bf16x8){S##l1[0], S##l1[1], S##l1[2], S##l1[3], S##h1[0], S##h1[1], S##h1[2], S##h1[3]}, o[d0], 0, 0, 0);   \
        o[d0] = __builtin_amdgcn_mfma_f32_32x32x16_bf16(pa2, (bf16x8){S##l2[0], S##l2[1], S##l2[2], S##l2[3], S##h2[0], S##h2[1], S##h2[2], S##h2[3]}, o[d0], 0, 0, 0);   \
        o[d0] = __builtin_amdgcn_mfma_f32_32x32x16_bf16(pa3, (bf16x8){S##l3[0], S##l3[1], S##l3[2], S##l3[3], S##h3[0], S##h3[1], S##h3[2], S##h3[3]}, o[d0], 0, 0, 0); } while (0)
    s16x4 Al0, Al1, Al2, Al3, Ah0, Ah1, Ah2, Ah3, Bl0, Bl1, Bl2, Bl3, Bh0, Bh1, Bh2, Bh3;
    PV_LD(A, 0);
    PV_LD(B, 1); asm volatile("s_waitcnt lgkmcnt(8)" ::: "memory"); SBAR(); PV_MM(A, 0); SBAR();
    PV_LD(A, 2); asm volatile("s_waitcnt lgkmcnt(8)" ::: "memory"); SBAR(); PV_MM(B, 1); SBAR();
    PV_LD(B, 3); asm volatile("s_waitcnt lgkmcnt(8)" ::: "memory"); SBAR(); PV_MM(A, 2); SBAR();
    asm volatile("s_waitcnt lgkmcnt(0)" ::: "memory"); SBAR(); PV_MM(B, 3);
#undef PV_LD
#undef PV_MM
#undef TRRD
}
__device__ __forceinline__ void sel_mask(f32x16& p0, f32x16& p1, bool keep) {
    const float NEG = -__builtin_inff();
#pragma unroll
    for (int r = 0; r < 16; ++r) { p0[r] = keep ? p0[r] : NEG; p1[r] = keep ? p1[r] : NEG; }
}
struct BlockRef { int bh; int blk; };
struct Tensors { const bf16* Q; const bf16* K; bf16* O; const float* KS; };
constexpr size_t VOFF = (size_t)64 * 1024 * 1024 / 2;
constexpr int KS_OFF = LDS_BYTES;
#define BR_Q(r) (T.Q + ((size_t)(r).bh * 2048 + (r).blk * 256) * D)
#define BR_K(r) (T.K + (size_t)(r).bh * 2048 * D)
#define BR_V(r) (T.K + VOFF + (size_t)(r).bh * 2048 * D)
#define BR_O(r) (T.O + ((size_t)((r).bh >> 3) * 2048 + (r).blk * 256) * LDO + ((r).bh & 7) * D)
#define BR_KS(r) (T.KS + (size_t)(r).bh * 8 * D)
struct Seam { bf16x8 qr[8]; bf16x8 st_v0, st_v1, st_k0, st_k1; };
#define ROW(p, k0, rr) ((p) + (size_t)((k0) + (rr)) * D + sc)
#define VMW() asm volatile("s_waitcnt vmcnt(0)" ::: "memory")
#define VMWN(n) asm volatile("s_waitcnt vmcnt(%0)" :: "i"(n) : "memory")
#define SLOAD_H(Kp, Vp, k0) do { unsigned lo__ = loff; asm volatile("" : "+v"(lo__)); const char* kb__ = (const char*)(Kp) + (size_t)(k0) * (D * 2); const char* vb__ = (const char*)(Vp) + (size_t)(k0) * (D * 2);   \
                         S.st_v0 = *(const bf16x8*)(vb__ + lo__); S.st_v1 = *(const bf16x8*)(vb__ + lo__ + 32 * D * 2);              \
                         S.st_k0 = *(const bf16x8*)(kb__ + lo__); S.st_k1 = *(const bf16x8*)(kb__ + lo__ + 32 * D * 2); } while (0)
#define SWRITE_HK(bf) do { *(bf16x8*)(K_lds + (bf) * SHM_K + kws) = S.st_k0; *(bf16x8*)(K_lds + (bf) * SHM_K + kws + 32 * 256) = S.st_k1; } while (0)
#define SWRITE_HV(bf) do { *(bf16x8*)(V_lds + (bf) * SHM_V + vst0) = S.st_v0; *(bf16x8*)(V_lds + (bf) * SHM_V + vst1) = S.st_v1; } while (0)
#define SWRITE_H(bf) do { SWRITE_HV(bf); SWRITE_HK(bf); } while (0)
__device__ __forceinline__ void moba_prime(const Tensors& T, const BlockRef& cur, char* lds, Seam& S) {
    const int tid = threadIdx.x, wid = __builtin_amdgcn_readfirstlane(tid >> 6), lane = tid & 63, r32 = lane & 31, hi = lane >> 5;
    const int sr = tid >> 4, sc = (tid & 15) * 8, kws = KSWZ(sr, sc * 2); char* K_lds = lds + 2 * SHM_V; const unsigned loff = (unsigned)(sr * D + sc) * 2u;
#pragma unroll
    for (int d0 = 0; d0 < 8; ++d0) S.qr[d0] = load8<bf16>(BR_Q(cur) + (size_t)(wid * QBLK + r32) * D + d0 * 16 + hi * 8);
    SLOAD_H(BR_K(cur), BR_V(cur), 0);
    if (tid < 256) { const f32x4 v = *(const f32x4*)(BR_KS(cur) + tid * 4); *(f32x4*)(lds + KS_OFF + tid * 16) = v; }
    VMW(); SWRITE_HK(0);
    __syncthreads();
}
__device__ __forceinline__ void moba_block(const Tensors& T, const BlockRef& cur, const BlockRef& nxt, char* lds, Seam& S) {
    const int tid = threadIdx.x, wid = __builtin_amdgcn_readfirstlane(tid >> 6), lane = tid & 63, r32 = lane & 31, hi = lane >> 5;
    const int blk = cur.blk, P0 = blk * QB;
    const int NT = (P0 + QB) / KVBLK;
    const int qlo = P0 + wid * QBLK, qm = qlo + r32 - 4 * hi;
    char* V_lds = lds; char* K_lds = lds + 2 * SHM_V;
    float* ws = (float*)(lds + 2 * SHM_V + 2 * SHM_K) + wid * 64; float* li_l = ws, * al_l = ws + 32;
    float m_reg = -1e30f, l_reg = 0;
    const int sr = tid >> 4, sc = (tid & 15) * 8, vst0 = v_st(sr, sc), vst1 = v_st(32 + sr, sc), kws = KSWZ(sr, sc * 2); const unsigned loff = (unsigned)(sr * D + sc) * 2u;
    const int vb0 = (int)(uintptr_t)V_lds + v_rd_base(lane);
    const bf16* Kh = BR_K(cur); const bf16* Vh = Kh + VOFF;
    unsigned sel = (1u << blk) - 1u;
#ifndef NO_GATE
    if (blk > 3) {
        float qf[64];
#pragma unroll
        for (int d0 = 0; d0 < 8; ++d0)
#pragma unroll
            for (int e = 0; e < 8; ++e) qf[d0 * 8 + e] = __uint_as_float(((unsigned)(unsigned short)S.qr[d0][e]) << 16);
        float b0 = -__builtin_inff(), b1 = b0, b2 = b0; unsigned i0 = 0u, i1 = 0u, i2 = 0u;
#pragma unroll 1
        for (int n = 0; n < blk; ++n) {
            const float* kp = (const float*)(lds + KS_OFF) + n * 128 + hi * 8;
            float g = 0.f;
#pragma unroll
            for (int d0 = 0; d0 < 8; ++d0) { const f32x4 a = *(const f32x4*)(kp + d0 * 16), b = *(const f32x4*)(kp + d0 * 16 + 4);
                g += (qf[d0 * 8 + 0] * a[0] + qf[d0 * 8 + 1] * a[1]) + (qf[d0 * 8 + 2] * a[2] + qf[d0 * 8 + 3] * a[3]) + (qf[d0 * 8 + 4] * b[0] + qf[d0 * 8 + 5] * b[1]) + (qf[d0 * 8 + 6] * b[2] + qf[d0 * 8 + 7] * b[3]); }
            { auto rr = __builtin_amdgcn_permlane32_swap(__float_as_uint(g), __float_as_uint(g), false, false); g = __uint_as_float(rr[0]) + __uint_as_float(rr[1]); }
            const unsigned bit = 1u << n;
            const bool c0 = g > b0, c1 = g > b1, c2 = g > b2;
            b2 = c1 ? b1 : (c2 ? g : b2); i2 = c1 ? i1 : (c2 ? bit : i2);
            b1 = c0 ? b0 : (c1 ? g : b1); i1 = c0 ? i0 : (c1 ? bit : i1);
            b0 = c0 ? g : b0;             i0 = c0 ? bit : i0;
        }
        sel = i0 | i1 | i2;
    }
#endif
    f32x16 o[4] = {};
#define RESC(a) do { if (__any((a) < 1.f)) { if (hi == 0) al_l[r32] = (a); asm volatile("s_waitcnt lgkmcnt(0)" ::: "memory");              \
                     for (int d_ = 0; d_ < 4; ++d_) for (int r = 0; r < 16; ++r) o[d_][r] *= al_l[crow(r, hi)]; } } while (0)
#define KBASE(t) ((t) * KVBLK)
#define MASKT(P0_, P1_, t) do { const int kb_ = KBASE(t); \
        if (kb_ >= P0) { if (kb_ + KVBLK - 1 > qlo) mask_tile(P0_, P1_, qm - kb_, 0x7fffffffu); } } while (0)
#define KEEPT(t) ((KBASE(t) >= P0) || (((sel >> ((t) >> 2)) & 1u) != 0u))
    constexpr int NQL = 8;
    constexpr bool SK = false;
#define SEAM_K0() do { VMWN(NQL); SWRITE_HK(0); SBAR(); } while (0)
    f32x16 pA0, pA1, pB0, pB1; float mnA, mnB, alA, alB; bf16x8 pa0, pa1, pa2, pa3;
    SWRITE_HV(0); SBAR();
    SLOAD_H(Kh, Vh, KBASE(1));
    SBAR(); qkt<0, SK>(pA0, pA1, K_lds, r32, hi, S.qr, true);
    MASKT(pA0, pA1, 0); partialSM(pA0, pA1, m_reg, mnA, alA, KEEPT(0));
    VMW(); SWRITE_H(1);
    __syncthreads();
#define HALF_STEP(PX0, PX1, mnX, alX, PY0, PY1, alY, t, KB, VB, SB) do {                                                      \
        SBAR(); if ((t) + 1 < NT) { SLOAD_H(Kh, Vh, KBASE((t) + 1)); SBAR(); }                                                \
        qkt<KB, SK>(PX0, PX1, K_lds, r32, hi, S.qr, true);                                                                    \
        finishSM(PY0, PY1, alY, l_reg, pa0, pa1, pa2, pa3); SBAR();                                                           \
        pv_tile<VB, SK>(o, vb0, pa0, pa1, pa2, pa3, true); MASKT(PX0, PX1, (t)); partialSM(PX0, PX1, m_reg, mnX, alX, KEEPT(t));        \
        __syncthreads();                                                                                                      \
        if ((t) + 1 < NT) { VMW(); SWRITE_H(SB); }                                                                            \
        RESC(alX); __syncthreads(); } while (0)
    for (int t = 1; t + 1 < NT; t += 2) {
        HALF_STEP(pB0, pB1, mnB, alB, pA0, pA1, alA, t, 1, 0, 0);
        HALF_STEP(pA0, pA1, mnA, alA, pB0, pB1, alB, t + 1, 0, 1, 1);
    }
    { SBAR(); qkt<1, SK>(pB0, pB1, K_lds, r32, hi, S.qr, true); SBAR(); }
    SLOAD_H(BR_K(nxt), BR_V(nxt), 0); SBAR();
    { unsigned qo__ = (unsigned)((wid * QBLK + r32) * D + hi * 8) * 2u; asm volatile("" : "+v"(qo__)); const char* qb__ = (const char*)BR_Q(nxt) + qo__;
#pragma unroll
      for (int d0 = 0; d0 < 8; ++d0) S.qr[d0] = *(const bf16x8*)(qb__ + d0 * 32); }
    SBAR();
    finishSM(pA0, pA1, alA, l_reg, pa0, pa1, pa2, pa3); SBAR();
    pv_tile<0, SK>(o, vb0, pa0, pa1, pa2, pa3, true);
    { MASKT(pB0, pB1, NT - 1); partialSM(pB0, pB1, m_reg, mnB, alB, KEEPT(NT - 1)); __syncthreads(); RESC(alB);
      finishSM(pB0, pB1, alB, l_reg, pa0, pa1, pa2, pa3); SBAR(); pv_tile<1, SK>(o, vb0, pa0, pa1, pa2, pa3, true); }
    SBAR(); SEAM_K0();
    if (hi == 0) li_l[r32] = l_reg; asm volatile("s_waitcnt lgkmcnt(0)" ::: "memory");
    float rli[16];
#pragma unroll
    for (int r = 0; r < 16; ++r) rli[r] = __builtin_amdgcn_rcpf(li_l[crow(r, hi)]);
    char* Ow = (char*)(BR_O(cur) + (size_t)(wid * QBLK) * LDO);
    unsigned oo__ = (unsigned)(4 * hi * LDO + r32) * 2u; asm volatile("" : "+v"(oo__));
#pragma unroll
    for (int r = 0; r < 16; ++r) { const int orow0 = (r & 3) + 8 * (r >> 2);
#pragma unroll
        for (int d0 = 0; d0 < 4; ++d0) { const float v = o[d0][r] * rli[r];
            const float vn = __shfl_xor(v, 1);
            if ((r32 & 1) == 0) *(unsigned*)(Ow + (size_t)(orow0 * LDO + d0 * 32) * 2 + oo__) = cvtpk(v, vn); } }
    if (tid < 256) { unsigned ko__ = (unsigned)tid * 16u; asm volatile("" : "+v"(ko__)); const f32x4 v = *(const f32x4*)((const char*)BR_KS(nxt) + ko__); *(f32x4*)(lds + KS_OFF + tid * 16) = v; }
    __syncthreads();
#undef RESC
#undef KBASE
#undef MASKT
#undef KEEPT
#undef SEAM_K0
#undef HALF_STEP
}
#undef ROW
#undef BR_Q
#undef BR_K
#undef BR_V
#undef BR_O
#undef BR_KS
#undef VMW
#undef VMWN
#undef SLOAD_H
#undef SWRITE_HK
#undef SWRITE_HV
#undef SWRITE_H
#undef SBAR
#undef KSWZ
}

#define LAS __attribute__((address_space(3)))
typedef unsigned short bf16_t;
typedef float f32x4 __attribute__((ext_vector_type(4)));
typedef float f32x2 __attribute__((ext_vector_type(2)));
typedef unsigned u32x4 __attribute__((ext_vector_type(4)));
typedef unsigned u32x2 __attribute__((ext_vector_type(2)));

constexpr int NTHREADS = 512, NWAVES = 8;
constexpr int RING_BYTES = 131072, LDS_BYTES = RING_BYTES + 4096;
constexpr size_t MiB = 1u << 20;
constexpr size_t WS_MOD = 0, WS_ROPEC = 1 * MiB, WS_ROPES = WS_ROPEC + 512 * 1024, WS_KSUM = 2 * MiB;
constexpr size_t WS_CTL = 3 * MiB;
constexpr size_t WS_WIN = 4 * MiB, WS_WOUT = 24 * MiB, WS_WGU = 32 * MiB, WS_WDN = 76 * MiB;
constexpr size_t WS_U = 98 * MiB, WS_Q = 226 * MiB, WS_K = 290 * MiB, WS_V = 354 * MiB, WS_GLU = 418 * MiB, WS_AC = 482 * MiB;
constexpr size_t WS_ACT = 226 * MiB;
constexpr size_t WS_H1 = 610 * MiB;
constexpr size_t WS_H2 = WS_U;
constexpr size_t WS_END = 738 * MiB;
static_assert(WS_WIN + (size_t)INW * DM * 2 <= WS_WOUT && WS_WOUT + (size_t)DM * DM * 2 <= WS_WGU && WS_WGU + (size_t)2 * DFF * DM * 2 <= WS_WDN && WS_WDN + (size_t)DM * DFF * 2 <= WS_U, "weights map");
static_assert(WS_U + (size_t)MROWS * DM * 2 <= WS_Q && WS_ACT + (size_t)MROWS * DFF * 2 <= WS_END && WS_AC + (size_t)MROWS * DM * 2 <= WS_END, "activation map");

struct Args {
    const float *x, *c, *w_ada, *b_ada, *g_mix, *w_in, *conv_w, *conv_b, *ln_g, *ln_b, *w_out, *g_ffn, *w_gate, *w_up, *w_down, *g_final;
    float* out; unsigned char* ws; int ph_lo, ph_hi;
};

__device__ const double INVREV[64] = {
1.59154943091895346e-01, 1.37822502603982849e-01, 1.19349370211248862e-01, 1.03352296618434064e-01,
8.94994016088910133e-02, 7.75032887553740585e-02, 6.71150830052272551e-02, 5.81192674418762462e-02,
5.03292121044870353e-02, 4.35833021053073297e-02, 3.77415847174197711e-02, 3.26828658723569976e-02,
2.83021958306233987e-02, 2.45086918620698521e-02, 2.12236527647776604e-02, 1.83789261056796667e-02,
1.59154943091895339e-02, 1.37822502603982839e-02, 1.19349370211248862e-02, 1.03352296618434061e-02,
8.94994016088910237e-03, 7.75032887553740550e-03, 6.71150830052272534e-03, 5.81192674418762410e-03,
5.03292121044870370e-03, 4.35833021053073314e-03, 3.77415847174197719e-03, 3.26828658723569932e-03,
2.83021958306233987e-03, 2.45086918620698521e-03, 2.12236527647776622e-03, 1.83789261056796667e-03,
1.59154943091895356e-03, 1.37822502603982878e-03, 1.19349370211248849e-03, 1.03352296618434048e-03,
8.94994016088910237e-04, 7.75032887553740507e-04, 6.71150830052272599e-04, 5.81192674418762388e-04,
5.03292121044870326e-04, 4.35833021053073292e-04, 3.77415847174197741e-04, 3.26828658723569922e-04,
2.83021958306233954e-04, 2.45086918620698543e-04, 2.12236527647776605e-04, 1.83789261056796662e-04,
1.59154943091895351e-04, 1.37822502603982856e-04, 1.19349370211248862e-04, 1.03352296618434061e-04,
8.94994016088910182e-05, 7.75032887553740561e-05, 6.71150830052272545e-05, 5.81192674418762388e-05,
5.03292121044870354e-05, 4.35833021053073225e-05, 3.77415847174197768e-05, 3.26828658723569989e-05,
2.83021958306233961e-05, 2.45086918620698523e-05, 2.12236527647776592e-05, 1.83789261056796682e-05
};

__device__ __forceinline__ unsigned f2bf(float f) { unsigned u = __builtin_bit_cast(unsigned, f); return (u + 0x7fffu + ((u >> 16) & 1u)) >> 16; }
__device__ __forceinline__ unsigned pk2(float lo, float hi) { return f2bf(lo) | (f2bf(hi) << 16); }
__device__ __forceinline__ float wave_sum(float v) {
#pragma unroll
    for (int o = 1; o < 64; o <<= 1) v += __shfl_xor(v, o);
    return v;
}
#define LDS_WAIT() asm volatile("s_waitcnt lgkmcnt(0)" ::: "memory")

__device__ __forceinline__ void transpose_item(const float* __restrict__ W, int N, int col0, int k0, bf16_t* __restrict__ WT, int K, int n0, LAS unsigned* scr, int lane) {
    {
        float v[64];
        const float* wp = W + (size_t)k0 * N + col0 + lane;
#pragma unroll
        for (int i = 0; i < 64; ++i) v[i] = __builtin_nontemporal_load(wp + (size_t)i * N);
#pragma unroll
        for (int i = 0; i < 32; ++i) scr[lane * 36 + i] = pg8::cvt_pk_bf16(v[2 * i], v[2 * i + 1]);
    }
    LDS_WAIT(); asm volatile("" ::: "memory");
#pragma unroll
    for (int j = 0; j < 8; ++j) { const int n = j * 8 + (lane >> 3), ch = lane & 7;
        const u32x4 o = *(const LAS u32x4*)(scr + n * 36 + ch * 4);
        *(u32x4*)(WT + (size_t)(n0 + n) * K + k0 + ch * 8) = o; }
    LDS_WAIT(); asm volatile("" ::: "memory");
}

__device__ __forceinline__ void phase0(const Args& a, LAS unsigned char* lds, int G) {
    const int tid = threadIdx.x, lane = tid & 63, wave = __builtin_amdgcn_readfirstlane(tid >> 6), bx = blockIdx.x;
    float* MOD = (float*)(a.ws + WS_MOD); float* RC = (float*)(a.ws + WS_ROPEC); float* RS = (float*)(a.ws + WS_ROPES); float* KSUM = (float*)(a.ws + WS_KSUM);
    if (bx == 0) { unsigned* ctl = (unsigned*)(a.ws + WS_CTL); for (int i = tid; i < 4096; i += NTHREADS) __hip_atomic_store(ctl + i, 0u, __ATOMIC_RELAXED, __HIP_MEMORY_SCOPE_AGENT); }
    {
        const int gt = bx * NTHREADS + tid, NT = G * NTHREADS;
        for (int i = gt; i < BATCH * NH * 8 * HD; i += NT) KSUM[i] = 0.f;
        for (int i = gt; i < SEQ * 64; i += NT) { const int t = i >> 6, j = i & 63; double rev = (double)t * INVREV[j]; rev -= __builtin_floor(rev); const float fr = (float)rev;
            RC[i] = __builtin_amdgcn_cosf(fr); RS[i] = __builtin_amdgcn_sinf(fr); }
    }
    for (int s = ((G % 8 == 0) ? (bx % 8) * (G / 8) + bx / 8 : bx); s < 256; s += G) {
        const int n0 = s * 48, kbeg = wave * 256, lb = lane & 15, kq = lane >> 4;
        float csr[64];
        { const float* cp = a.c + (size_t)lb * DM + kbeg + kq;
#pragma unroll
          for (int j = 0; j < 64; ++j) { const float cv = cp[4 * j]; csr[j] = cv * __builtin_amdgcn_rcpf(1.0f + __expf(-cv)); } }
        f32x4 acc0 = (f32x4){0.f, 0.f, 0.f, 0.f}, acc1 = acc0, acc2 = acc0;
        const float* wp = a.w_ada + (size_t)(kbeg + kq) * NMODC + n0 + lb;
#pragma unroll
        for (int j = 0; j < 64; ++j) {
            const float w0 = wp[(size_t)(4 * j) * NMODC], w1 = wp[(size_t)(4 * j) * NMODC + 16], w2 = wp[(size_t)(4 * j) * NMODC + 32];
            acc0 = __builtin_amdgcn_mfma_f32_16x16x4f32(csr[j], w0, acc0, 0, 0, 0);
            acc1 = __builtin_amdgcn_mfma_f32_16x16x4f32(csr[j], w1, acc1, 0, 0, 0);
            acc2 = __builtin_amdgcn_mfma_f32_16x16x4f32(csr[j], w2, acc2, 0, 0, 0);
        }
        LAS float* red = (LAS float*)lds;
#pragma unroll
        for (int e = 0; e < 4; ++e) { LAS float* rp = red + (wave * 16 + 4 * kq + e) * 48 + lb; rp[0] = acc0[e]; rp[16] = acc1[e]; rp[32] = acc2[e]; }
        __syncthreads();
        for (int i = tid; i < 16 * 48; i += NTHREADS) { const int b = i / 48, l = i - b * 48; float sum = a.b_ada[n0 + l];
#pragma unroll
            for (int w = 0; w < 8; ++w) sum += red[(w * 16 + b) * 48 + l];
            MOD[(size_t)b * NMODC + n0 + l] = sum; }
        __syncthreads();
    }
}

constexpr int I_IN = 32 * 80, I_OUT = 32 * 32, I_GU = 32 * 176, I_DN = 88 * 32;
__device__ __forceinline__ void weight_copies(const Args& a, LAS unsigned char* lds, int G, const int it_lo, const int it_hi) {
    const int tid = threadIdx.x, lane = tid & 63, wave = __builtin_amdgcn_readfirstlane(tid >> 6), bx = blockIdx.x;
    {
        LAS unsigned* scr = (LAS unsigned*)lds + wave * 2304;
        bf16_t* WIN = (bf16_t*)(a.ws + WS_WIN); bf16_t* WOUT = (bf16_t*)(a.ws + WS_WOUT); bf16_t* WGU = (bf16_t*)(a.ws + WS_WGU); bf16_t* WDN = (bf16_t*)(a.ws + WS_WDN);
        const int gw = bx * NWAVES + wave, NGW = G * NWAVES;
        for (int it = it_lo + gw; it < it_hi; it += NGW) {
            int r = it;
            if (r < I_IN) { const int kb = r / 80, nb = r - kb * 80, n0 = nb * 64; int col0;
                if (n0 < 2048) col0 = (n0 & ~0xC0) | ((n0 & 0x40) << 1) | ((n0 & 0x80) >> 1);
                else if (n0 < 3072) col0 = n0;
                else { const int j = n0 - 3072; col0 = 3072 + ((j >> 7) & 1) * 1024 + (j >> 8) * 128 + (j & 127); }
                transpose_item(a.w_in, INW, col0, kb * 64, WIN, DM, n0, scr, lane); continue; }
            r -= I_IN;
            if (r < I_OUT) { const int kb = r >> 5, nb = r & 31; transpose_item(a.w_out, DM, nb * 64, kb * 64, WOUT, DM, nb * 64, scr, lane); continue; }
            r -= I_OUT;
            if (r < I_GU) { const int kb = r / 176, nb = r - kb * 176, n0 = nb * 64; const int col0 = (n0 >> 8) * 128 + (n0 & 127);
                transpose_item(((n0 >> 7) & 1) ? a.w_up : a.w_gate, DFF, col0, kb * 64, WGU, DM, n0, scr, lane); continue; }
            r -= I_GU;
            { const int kb = r >> 5, nb = r & 31; transpose_item(a.w_down, DM, nb * 64, kb * 64, WDN, DFF, nb * 64, scr, lane); }
        }
    }
}

template <int MODE, bool SRC_BF16>
__device__ __forceinline__ void rows_phase(const void* src, const float* __restrict__ g, const float* __restrict__ sc, const float* __restrict__ sh, bf16_t* __restrict__ dst, float* __restrict__ dstf, int G) {
    const int tid = threadIdx.x, lane = tid & 63, wave = __builtin_amdgcn_readfirstlane(tid >> 6);
    const int gw = blockIdx.x * NWAVES + wave, NGW = G * NWAVES;
    for (int it = gw; it < MROWS / 16; it += NGW) {
        const int row0 = it * 16, b = row0 >> 11;
        f32x4 pa[4][2], pb[4][2];
#pragma unroll
        for (int j = 0; j < 4; ++j)
#pragma unroll
            for (int h = 0; h < 2; ++h) { const int col = 8 * lane + 512 * j + 4 * h; pa[j][h] = *(const f32x4*)(g + col);
                if (MODE == 0) { pa[j][h] = pa[j][h] * (*(const f32x4*)(sc + (size_t)b * NMODC + col) + 1.0f); pb[j][h] = *(const f32x4*)(sh + (size_t)b * NMODC + col); } }
#pragma unroll 2
        for (int r = 0; r < 16; ++r) {
            const size_t roff = (size_t)(row0 + r) * DM + 8 * lane;
            f32x4 v[4][2]; float ss = 0.f;
#pragma unroll
            for (int j = 0; j < 4; ++j) {
                if (SRC_BF16) { const u32x4 w = __builtin_nontemporal_load((const u32x4*)((const bf16_t*)src + roff + 512 * j));
                    v[j][0] = (f32x4){__uint_as_float(w.x << 16), __uint_as_float(w.x & 0xffff0000u), __uint_as_float(w.y << 16), __uint_as_float(w.y & 0xffff0000u)};
                    v[j][1] = (f32x4){__uint_as_float(w.z << 16), __uint_as_float(w.z & 0xffff0000u), __uint_as_float(w.w << 16), __uint_as_float(w.w & 0xffff0000u)}; }
                else { v[j][0] = __builtin_nontemporal_load((const f32x4*)((const float*)src + roff + 512 * j)); v[j][1] = __builtin_nontemporal_load((const f32x4*)((const float*)src + roff + 512 * j + 4)); }
#pragma unroll
                for (int h = 0; h < 2; ++h) ss += (v[j][h][0] * v[j][h][0] + v[j][h][1] * v[j][h][1]) + (v[j][h][2] * v[j][h][2] + v[j][h][3] * v[j][h][3]); }
            const float rstd = 1.0f / sqrtf(wave_sum(ss) * (1.0f / DM) + EPS);
            if (MODE == 0) {
#pragma unroll
                for (int j = 0; j < 4; ++j) { const f32x4 o0 = v[j][0] * rstd * pa[j][0] + pb[j][0], o1 = v[j][1] * rstd * pa[j][1] + pb[j][1];
                    *(u32x4*)(dst + roff + 512 * j) = pg8::pack8(o0, o1); } }
            else {
#pragma unroll
                for (int j = 0; j < 4; ++j) { *(f32x4*)(dstf + roff + 512 * j) = v[j][0] * rstd * pa[j][0]; *(f32x4*)(dstf + roff + 512 * j + 4) = v[j][1] * rstd * pa[j][1]; } }
        }
    }
}

#ifndef P3_REP
#define P3_REP 1
#endif
__device__ __forceinline__ void conv_phase(const Args& a, LAS unsigned char* lds, int G) {
    const int tid = threadIdx.x, lane = tid & 63, wave = __builtin_amdgcn_readfirstlane(tid >> 6);
    const bf16_t* GLU = (const bf16_t*)(a.ws + WS_GLU); bf16_t* AC = (bf16_t*)(a.ws + WS_AC);
    LAS float* red = (LAS float*)lds;
    LAS float* stat = red + 128;
    f32x2 w[CK];
#pragma unroll
    for (int j = 0; j < CK; ++j) w[j] = *(const f32x2*)(a.conv_w + j * CW + 2 * tid);
    const f32x2 bias = *(const f32x2*)(a.conv_b + 2 * tid), lg = *(const f32x2*)(a.ln_g + 2 * tid), lb = *(const f32x2*)(a.ln_b + 2 * tid);
    for (int ctr = blockIdx.x; ctr < P3_REP * (MROWS / 32); ctr += G) { const int ct = ctr % (MROWS / 32);
        const int row0 = ct * 32, t0 = row0 & (SEQ - 1);
        const unsigned* up = (const unsigned*)GLU + (size_t)row0 * (CW / 2) + tid;
        f32x2 x[38];
#pragma unroll
        for (int j = 0; j < 30; ++j) { unsigned p = 0u; if (t0 != 0) p = up[(j - 30) * (CW / 2)]; x[j] = (f32x2){__uint_as_float(p << 16), __uint_as_float(p & 0xffff0000u)}; }
        unsigned nx[8];
#pragma unroll
        for (int o = 0; o < 8; ++o) nx[o] = up[o * (CW / 2)];
        for (int it = 0; it < 4; ++it) {
#pragma unroll
            for (int o = 0; o < 8; ++o) { const unsigned p = nx[o]; x[30 + o] = (f32x2){__uint_as_float(p << 16), __uint_as_float(p & 0xffff0000u)}; }
            if (it < 3) {
#pragma unroll
                for (int o = 0; o < 8; ++o) nx[o] = up[((it + 1) * 8 + o) * (CW / 2)]; }
            f32x2 y[8];
#pragma unroll
            for (int o = 0; o < 8; ++o) y[o] = bias;
#pragma unroll
            for (int j = 0; j < CK; ++j)
#pragma unroll
                for (int o = 0; o < 8; ++o) y[o] += w[j] * x[o + j];
            float sv[16];
#pragma unroll
            for (int o = 0; o < 8; ++o) { sv[2 * o] = y[o][0] + y[o][1]; sv[2 * o + 1] = y[o][0] * y[o][0] + y[o][1] * y[o][1]; }
#pragma unroll
            for (int i = 0; i < 16; ++i) sv[i] = wave_sum(sv[i]);
            if (lane == 0) {
#pragma unroll
                for (int i = 0; i < 16; ++i) red[wave * 16 + i] = sv[i]; }
            __syncthreads();
            if (tid < 8) { float s = 0.f, q = 0.f;
#pragma unroll
                for (int wv = 0; wv < 8; ++wv) { s += red[wv * 16 + 2 * tid]; q += red[wv * 16 + 2 * tid + 1]; }
                const float mean = s * (1.0f / CW), var = q * (1.0f / CW) - mean * mean;
                stat[2 * tid] = mean; stat[2 * tid + 1] = 1.0f / sqrtf(fmaxf(var, 0.f) + EPS); }
            __syncthreads();
#pragma unroll
            for (int o = 0; o < 8; ++o) { const float mean = stat[2 * o], rstd = stat[2 * o + 1];
                const f32x2 yn = (y[o] - mean) * rstd * lg + lb;
                const float o0 = yn[0] * pg8::sigmoid_fast(yn[0]), o1 = yn[1] * pg8::sigmoid_fast(yn[1]);
                *((unsigned*)(AC + (size_t)(row0 + it * 8 + o) * DM + CW) + tid) = pk2(o0, o1); }
#pragma unroll
            for (int j = 0; j < 30; ++j) x[j] = x[j + 8];
        }
    }
}

__device__ __forceinline__ att::BlockRef attn_ref(int vcu, int G, int s) {
    const int Lv = vcu + (s >> 1) * G, y = Lv & 3;
    att::BlockRef r; r.bh = Lv >> 2; r.blk = (s & 1) ? 7 - y : y;
    return r;
}
__device__ __forceinline__ void attn_phase(const Args& a, char* lds, int vcu, int G) {
    static_assert(WS_V - WS_K == 64 * MiB, "att::VOFF");
    int nitems = 0; for (int i = 0; vcu + i * G < BATCH * NH * 4; ++i) ++nitems;
    const int ns = 2 * nitems; if (ns == 0) return;
    att::Tensors T; T.Q = (const bf16_t*)(a.ws + WS_Q); T.K = (const bf16_t*)(a.ws + WS_K); T.O = (bf16_t*)(a.ws + WS_AC); T.KS = (const float*)(a.ws + WS_KSUM);
    att::Seam S; att::BlockRef cur = attn_ref(vcu, G, 0);
    att::moba_prime(T, cur, lds, S);
#ifndef P3_REP
#define P3_REP 1
#endif
    for (int s = 0; s < ns * P3_REP; ++s) {
        const att::BlockRef nxt = (s + 1 < ns * P3_REP) ? attn_ref(vcu, G, (s + 1) % ns) : cur;
        att::moba_block(T, cur, nxt, lds, S);
        cur = nxt;
    }
}

#define RLX_AGENT __ATOMIC_RELAXED, __HIP_MEMORY_SCOPE_AGENT
#define XB_TMO      128
#define XB_XCNT(j)  (256  + 64 * (j))
#define XB_XSUB(j)  (1280 + 64 * (j))
#define XB_XGEN(j)  (2304 + 64 * (j))
#define XB_TOP      3328
#define XB_TOPGEN   3392
#define XCD_BAR_WORDS 3456
#define XB_SPIN_CAP (1u << 18)

__device__ __forceinline__ unsigned xb_ld(unsigned* p)              { return __hip_atomic_load(p, __ATOMIC_RELAXED, __HIP_MEMORY_SCOPE_AGENT); }
__device__ __forceinline__ unsigned xb_add(unsigned* p, unsigned v) { return __hip_atomic_fetch_add(p, v, __ATOMIC_RELAXED, __HIP_MEMORY_SCOPE_AGENT); }
__device__ __forceinline__ unsigned xb_xcc_id() { return (unsigned)__builtin_amdgcn_s_getreg((3 << 11) | 20) & 0xFu; }
#define XB_SPIN(cond, bar) do { unsigned _sp = 0; while (cond) { __builtin_amdgcn_s_sleep(1); \
    if ((++_sp & 255u) == 0u) { if (xb_ld(&(bar)[XB_TMO])) break; if (_sp > XB_SPIN_CAP) { atomicAdd(&(bar)[XB_TMO], 1u); break; } } } } while (0)

struct XcdBarrier {
    unsigned* bar; unsigned x;
    volatile LAS unsigned* st;
};

__device__ __forceinline__ XcdBarrier xcd_barrier_post(unsigned* bar, volatile LAS unsigned* st) {
    XcdBarrier b; b.bar = bar; b.x = xb_xcc_id(); b.st = st;
    if (threadIdx.x == 0) (void)xb_add(&bar[XB_XCNT(b.x)], 1u);
    return b;
}
__device__ __forceinline__ void xcd_barrier_complete(unsigned* bar, unsigned x, unsigned& nloc, unsigned& nx) {
    const unsigned G = gridDim.x * gridDim.y * gridDim.z;
    unsigned sum, cnt, mine, sp = 0u;
    for (;;) {
        sum = 0u; cnt = 0u; mine = 0u;
#pragma unroll
        for (unsigned j = 0; j < 16; ++j) { const unsigned c = xb_ld(&bar[XB_XCNT(j)]); sum += c; cnt += (c > 0u) ? 1u : 0u; mine = (j == x) ? c : mine; }
        if (sum == G) break;
        __builtin_amdgcn_s_sleep(1);
        if ((++sp & 255u) == 0u) { if (xb_ld(&bar[XB_TMO])) break; if (sp > XB_SPIN_CAP) { atomicAdd(&bar[XB_TMO], 1u); break; } }
    }
    nloc = mine > 0u ? mine : 1u; nx = cnt > 0u ? cnt : 1u;
}

__device__ __forceinline__ void xcd_barrier(const XcdBarrier& b) {
    asm volatile("s_waitcnt vmcnt(0)" ::: "memory");
    __syncthreads();
    if (threadIdx.x == 0) {
        unsigned* bar = b.bar;
        __builtin_amdgcn_s_waitcnt(0);
        unsigned nloc = b.st[0], nx = b.st[1];
        if (nloc == 0u) { xcd_barrier_complete(bar, b.x, nloc, nx); b.st[0] = nloc; b.st[1] = nx; }
        const unsigned old = xb_add(&bar[XB_XSUB(b.x)], 1u);
        const unsigned gen = old / nloc;
        if (old + 1u == (gen + 1u) * nloc) {
            __builtin_amdgcn_fence(__ATOMIC_RELEASE, "agent");
            asm volatile("s_waitcnt vmcnt(0)" ::: "memory");
            const unsigned og = xb_add(&bar[XB_TOP], 1u);
            const unsigned tg = og / nx;
            if (og + 1u == (tg + 1u) * nx) xb_add(&bar[XB_TOPGEN], 1u);
            else XB_SPIN(xb_ld(&bar[XB_TOPGEN]) == tg, bar);
            __builtin_amdgcn_fence(__ATOMIC_ACQUIRE, "agent");
            xb_add(&bar[XB_XGEN(b.x)], 1u);
            asm volatile("s_waitcnt vmcnt(0)" ::: "memory");
        } else {
            XB_SPIN(xb_ld(&bar[XB_XGEN(b.x)]) == gen, bar);
            __builtin_amdgcn_fence(__ATOMIC_ACQUIRE, "agent");
            asm volatile("s_waitcnt vmcnt(0)" ::: "memory");
        }
    }
    __syncthreads();
}

typedef const __attribute__((address_space(4))) Args* ArgsP;
__device__ __forceinline__ Args load_args() {
#if defined(__HIP_DEVICE_COMPILE__)
    ArgsP p = (ArgsP)__builtin_amdgcn_kernarg_segment_ptr(); asm volatile("" : "+s"(p)); return *p;
#else
    return Args{};
#endif
}
__global__ void __launch_bounds__(NTHREADS, 2) mega_fwd(Args a_unused) {
    extern __shared__ __attribute__((aligned(16))) unsigned char lds_raw[];
    LAS unsigned char* lds = (LAS unsigned char*)lds_raw;
    const int G = gridDim.x, bx = blockIdx.x;
    const int vcu = (G % 8 == 0) ? (bx % 8) * (G / 8) + bx / 8 : bx;
    cg::grid_group grid = cg::this_grid();
    volatile LAS unsigned* bst = (volatile LAS unsigned*)(lds + RING_BYTES);
    if (threadIdx.x < 4) bst[threadIdx.x] = 0u;
    __syncthreads();
    XcdBarrier bar; bar.bar = nullptr; bar.x = 0; bar.st = bst;
    const int lo = a_unused.ph_lo, hi = a_unused.ph_hi;
#ifndef PH_MASK
#define PH_MASK 0x1ff
#endif
#ifndef REP_MASK
#define REP_MASK 0
#endif
#define IN(k) (((PH_MASK >> (k)) & 1) && lo <= (k) && (k) < hi)
#define REP(k) for (int rep_ = 0; rep_ < 1 + ((REP_MASK >> (k)) & 1); ++rep_)
#define SEAM(k) do { if (IN(k) && IN((k) + 1)) { if ((k) == 0) { grid.sync(); bar = xcd_barrier_post((unsigned*)(load_args().ws + WS_CTL), bst); } else xcd_barrier(bar); } } while (0)
    if (IN(0)) REP(0) { const Args a = load_args(); phase0(a, lds, G); } SEAM(0);
    if (IN(1)) REP(1) { const Args a = load_args(); float* MOD = (float*)(a.ws + WS_MOD); rows_phase<0, false>(a.x, a.g_mix, MOD + DM, MOD, (bf16_t*)(a.ws + WS_U), nullptr, G); weight_copies(a, lds, G, 0, I_IN + I_OUT); } SEAM(1);
    if (IN(2)) REP(2) { const Args a = load_args();
        pg8::Gemm g{(const bf16_t*)(a.ws + WS_U), (const bf16_t*)(a.ws + WS_WIN), MROWS, INW, DM}; pg8::StaticOrder S; S.init(MROWS, INW, G, bx, 4); S.rot = 2;
        pg8::EpiIn E{(bf16_t*)(a.ws + WS_Q), (bf16_t*)(a.ws + WS_K), (bf16_t*)(a.ws + WS_V), (bf16_t*)(a.ws + WS_GLU), (float*)(a.ws + WS_KSUM), (const float*)(a.ws + WS_ROPEC), (const float*)(a.ws + WS_ROPES)};
        pg8::gemm_phase<pg8::EpiIn, pg8::StaticOrder, true, true>(lds, g, S, E);
    } SEAM(2);
    if (IN(3)) REP(3) {
#ifndef NO_ATTN
        { const Args a = load_args(); attn_phase(a, (char*)lds_raw, vcu, G); } __syncthreads();
#endif
#ifndef NO_CONV
        { const Args a = load_args(); conv_phase(a, lds, G); } __syncthreads();
#endif
    } SEAM(3);
    if (IN(4)) REP(4) { const Args a = load_args();
        pg8::Gemm g{(const bf16_t*)(a.ws + WS_AC), (const bf16_t*)(a.ws + WS_WOUT), MROWS, DM, DM}; pg8::StaticOrder S; S.init(MROWS, DM, G, bx, 4);
        pg8::EpiRes<false> E{a.x, (bf16_t*)(a.ws + WS_H1), (const float*)(a.ws + WS_MOD) + 2 * DM};
        pg8::gemm_phase<pg8::EpiRes<false>, pg8::StaticOrder, true, true>(lds, g, S, E);
    } SEAM(4);
    if (IN(5)) REP(5) { const Args a = load_args(); float* MOD = (float*)(a.ws + WS_MOD); weight_copies(a, lds, G, I_IN + I_OUT, I_IN + I_OUT + I_GU + I_DN); rows_phase<0, true>(a.ws + WS_H1, a.g_ffn, MOD + 4 * DM, MOD + 3 * DM, (bf16_t*)(a.ws + WS_U), nullptr, G); } SEAM(5);
    if (IN(6)) REP(6) { const Args a = load_args();
        pg8::Gemm g{(const bf16_t*)(a.ws + WS_U), (const bf16_t*)(a.ws + WS_WGU), MROWS, 2 * DFF, DM}; pg8::StaticOrder S; S.init(MROWS, 2 * DFF, G, bx, 4); S.rot = 5;
        pg8::EpiGU E{(bf16_t*)(a.ws + WS_ACT)};
        pg8::gemm_phase<pg8::EpiGU, pg8::StaticOrder, true, true>(lds, g, S, E);
    } SEAM(6);
    if (IN(7)) REP(7) { const Args a = load_args();
        pg8::Gemm g{(const bf16_t*)(a.ws + WS_ACT), (const bf16_t*)(a.ws + WS_WDN), MROWS, DM, DFF}; pg8::StaticOrder S; S.init(MROWS, DM, G, bx, 4); S.rev = 1;
        pg8::EpiRes<true> E{a.ws + WS_H1, (bf16_t*)(a.ws + WS_H2), (const float*)(a.ws + WS_MOD) + 5 * DM};
        pg8::gemm_phase<pg8::EpiRes<true>, pg8::StaticOrder, true, true>(lds, g, S, E);
    } SEAM(7);
    if (IN(8)) REP(8) { const Args a = load_args(); rows_phase<1, true>(a.ws + WS_H2, a.g_final, nullptr, nullptr, nullptr, a.out, G); }
#undef IN
#undef SEAM
}

#ifndef MK_N_LAUNCHES
#define MK_N_LAUNCHES 1
#endif
extern "C" void kernel_launch(void* const* d_in, const int* in_sizes, int n_in, void* d_out, int out_size, void* d_ws, size_t ws_size, hipStream_t stream) {
    static int grid = 0;
    if (grid == 0) {
        if (n_in != 16 || in_sizes[0] != MROWS * DM || out_size != MROWS * DM || ws_size < WS_END) {
            fprintf(stderr, "kernel_launch: unexpected shapes (n_in %d, in0 %d, out %d, ws %zu); nothing launched\n", n_in, n_in > 0 ? in_sizes[0] : -1, out_size, ws_size); grid = -1; return; }
        int dev = 0, cus = 0, per_cu = 0;
        (void)hipGetDevice(&dev); (void)hipDeviceGetAttribute(&cus, hipDeviceAttributeMultiprocessorCount, dev);
        if (hipFuncSetAttribute((const void*)mega_fwd, hipFuncAttributeMaxDynamicSharedMemorySize, LDS_BYTES) != hipSuccess) { fprintf(stderr, "kernel_launch: hipFuncSetAttribute failed\n"); grid = -1; return; }
        if (hipOccupancyMaxActiveBlocksPerMultiprocessor(&per_cu, (const void*)mega_fwd, NTHREADS, LDS_BYTES) != hipSuccess || per_cu < 1) { fprintf(stderr, "kernel_launch: occupancy query gave %d\n", per_cu); per_cu = 1; }
        (void)hipGetLastError();
        if (cus <= 0) cus = 256;
        grid = cus * per_cu;
        fprintf(stderr, "kernel_launch: grid %d (cus %d x %d)\n", grid, cus, per_cu);
    }
    if (grid < 0) return;
    Args a{};
    a.x = (const float*)d_in[0]; a.c = (const float*)d_in[1]; a.w_ada = (const float*)d_in[2]; a.b_ada = (const float*)d_in[3]; a.g_mix = (const float*)d_in[4];
    a.w_in = (const float*)d_in[5]; a.conv_w = (const float*)d_in[6]; a.conv_b = (const float*)d_in[7]; a.ln_g = (const float*)d_in[8]; a.ln_b = (const float*)d_in[9];
    a.w_out = (const float*)d_in[10]; a.g_ffn = (const float*)d_in[11]; a.w_gate = (const float*)d_in[12]; a.w_up = (const float*)d_in[13]; a.w_down = (const float*)d_in[14]; a.g_final = (const float*)d_in[15];
    a.out = (float*)d_out; a.ws = (unsigned char*)d_ws;
    constexpr int NPH = 9;
    if (MK_N_LAUNCHES == 1) {
        a.ph_lo = 0; a.ph_hi = NPH;
        void* args[] = {&a};
        const hipError_t e = hipLaunchCooperativeKernel((const void*)mega_fwd, dim3(grid), dim3(NTHREADS), args, LDS_BYTES, stream);
        if (e != hipSuccess) fprintf(stderr, "kernel_launch: cooperative launch failed: %s (grid %d)\n", hipGetErrorString(e), grid);
    } else {
        for (int p = 0; p < NPH; ++p) { a.ph_lo = p; a.ph_hi = p + 1; hipLaunchKernelGGL(mega_fwd, dim3(grid), dim3(NTHREADS), LDS_BYTES, stream, a); }
    }
}
```

```cpp
#include <hip/hip_runtime.h>
#include <hip/hip_cooperative_groups.h>
#include <cstdio>
#include <cstdint>
namespace cg = cooperative_groups;

constexpr int DM = 2048, BATCH = 16, SEQ = 2048, MROWS = BATCH * SEQ;
constexpr int NH = 8, HD = 128, AW = 1024, CW = 1024, INW = 5120, CK = 31, DFF = 5632, NMODC = 6 * DM;
constexpr float EPS = 1e-6f;

namespace pg8 {
#define PG8_LAS __attribute__((address_space(3)))
typedef unsigned short bf16_t;
typedef short bf16x8 __attribute__((ext_vector_type(8)));
typedef float f32x4 __attribute__((ext_vector_type(4)));
typedef unsigned u32x4 __attribute__((ext_vector_type(4)));
constexpr int BM = 256, BK = 64, HALF = 128, HTB = HALF * BK * 2  , STAGE_BYTES = 8 * HTB, NXCD = 8, WGM = 8;

__host__ __device__ __forceinline__ int lds_byte(int r, int c) { const int st = (r >> 4) * 2 + (c >> 5), rr = r & 15, cc = c & 31, ob = rr * 64 + cc * 2; return st * 1024 + (ob ^ (((ob >> 9) & 1) << 5)); }
__host__ __device__ __forceinline__ void stage_rc(int b, int& R, int& C) { const int st = b / 1024, sb = b % 1024, swz = sb ^ (((sb >> 9) & 1) << 5); R = (st >> 1) * 16 + swz / 64; C = (st & 1) * 32 + (swz % 64) / 2; }
__host__ __device__ __forceinline__ int perm32(int rho) { const int n = rho >> 4, i = rho & 15; return 8 * (i >> 2) + 4 * n + (i & 3); }

struct Unit { int pm, pn; };
struct Gemm { const bf16_t* A; const bf16_t* Bt; int M, N, K; };

struct StaticOrder {
    int nM, nN, nwg, G, c, wgm, rev = 0;
    __host__ __device__ void init(int M, int N, int G_, int c_, int wgm_ = WGM) { nM = M / BM; nN = N / BM; nwg = nM * nN; G = G_; c = c_; wgm = wgm_; }
    __host__ __device__ bool next(int i, Unit& u) const {
        const long L = (long)i * G + c; if (L >= nwg) return false;
        int wgid = (int)L; { const int q = nwg / NXCD, r = nwg % NXCD, xcd = wgid % NXCD, off = wgid / NXCD; wgid = (xcd < r ? xcd * (q + 1) : r * (q + 1) + (xcd - r) * q) + off; }
        const int nig = wgm * nN, gid = wgid / nig, fm = gid * wgm, gsz = (nM - fm) < wgm ? (nM - fm) : wgm;
        u.pm = fm + ((wgid % nig) % gsz); u.pn = (wgid % nig) / gsz; if (rev) u.pm = (u.pm & ~15) | (15 - (u.pm & 15)); return true;
    }
    __device__ __forceinline__ void a_ready(const Unit&) const {}
    __device__ __forceinline__ void done(const Unit&) const {}
};


__device__ __forceinline__ unsigned cvt_pk_bf16(float lo, float hi) { unsigned r; asm volatile("v_cvt_pk_bf16_f32 %0, %1, %2" : "=v"(r) : "v"(lo), "v"(hi)); return r; }
__device__ __forceinline__ float sigmoid_fast(float x) { return __builtin_amdgcn_rcpf(1.0f + __builtin_amdgcn_exp2f(-1.4426950408889634f * x)); }
__device__ __forceinline__ u32x4 pack8(const f32x4 a, const f32x4 b) { u32x4 w; w.x = cvt_pk_bf16(a[0], a[1]); w.y = cvt_pk_bf16(a[2], a[3]); w.z = cvt_pk_bf16(b[0], b[1]); w.w = cvt_pk_bf16(b[2], b[3]); return w; }

struct EpiIn {
    static constexpr bool PERM = true, AFTER_DRAIN = false;
    bf16_t* Q; bf16_t* K; bf16_t* V; bf16_t* GLU; float* KSUM; const float* RC; const float* RS;
    __device__ __forceinline__ void operator()(const f32x4 (&acc)[2][2][4][2], const Unit& u, int wr, int wc, int fr, int fq) const {
        const int b = u.pm >> 3, blk = u.pm & 7, pn = u.pn;
        const int t0 = blk * 256 + wr * 64 + fr;
        if (pn < 8) {
            const int hh = (pn & 3) * 2 + (wc >> 1), dl = (wc & 1) * 32 + fq * 8;
            const bool isk = pn >= 4;
            bf16_t* dst = (isk ? K : Q) + (size_t)(b * NH + hh) * SEQ * HD + dl;
            f32x4 ks[2][2];
#pragma unroll
            for (int i = 0; i < 2; ++i)
#pragma unroll
                for (int j = 0; j < 2; ++j) ks[i][j] = (f32x4){0.f, 0.f, 0.f, 0.f};
#pragma unroll
            for (int ai = 0; ai < 2; ++ai)
#pragma unroll
                for (int m = 0; m < 4; ++m) {
                    const int t = t0 + ai * 128 + m * 16;
                    const f32x4 c0 = *(const f32x4*)(RC + t * 64 + dl), c1 = *(const f32x4*)(RC + t * 64 + dl + 4);
                    const f32x4 s0 = *(const f32x4*)(RS + t * 64 + dl), s1 = *(const f32x4*)(RS + t * 64 + dl + 4);
                    const f32x4 a0 = acc[ai][0][m][0], a1 = acc[ai][0][m][1], b0 = acc[ai][1][m][0], b1 = acc[ai][1][m][1];
                    const f32x4 o10 = a0 * c0 - b0 * s0, o11 = a1 * c1 - b1 * s1, o20 = b0 * c0 + a0 * s0, o21 = b1 * c1 + a1 * s1;
                    *(u32x4*)(dst + (size_t)t * HD) = pack8(o10, o11);
                    *(u32x4*)(dst + (size_t)t * HD + 64) = pack8(o20, o21);
                    ks[0][0] += o10; ks[0][1] += o11; ks[1][0] += o20; ks[1][1] += o21;
                    asm volatile("" ::: "memory");
                }
            if (isk) {
#pragma unroll
                for (int i = 0; i < 2; ++i)
#pragma unroll
                    for (int j = 0; j < 2; ++j)
#pragma unroll
                        for (int e = 0; e < 4; ++e) { float v = ks[i][j][e]; v += __shfl_xor(v, 1); v += __shfl_xor(v, 2); v += __shfl_xor(v, 4); v += __shfl_xor(v, 8); ks[i][j][e] = v; }
                if (fr == 0) { float* kp = KSUM + ((size_t)(b * NH + hh) * 8 + blk) * HD + dl;
#pragma unroll
                    for (int i = 0; i < 2; ++i)
#pragma unroll
                        for (int j = 0; j < 2; ++j)
#pragma unroll
                            for (int e = 0; e < 4; ++e) atomicAdd(kp + i * 64 + j * 4 + e, ks[i][j][e]); }
            }
        } else if (pn < 12) {
#pragma unroll
            for (int bj = 0; bj < 2; ++bj) {
                bf16_t* dst = V + (size_t)(b * NH + (pn - 8) * 2 + bj) * SEQ * HD + wc * 32 + fq * 8;
#pragma unroll
                for (int ai = 0; ai < 2; ++ai)
#pragma unroll
                    for (int m = 0; m < 4; ++m) { const int t = t0 + ai * 128 + m * 16; *(u32x4*)(dst + (size_t)t * HD) = pack8(acc[ai][bj][m][0], acc[ai][bj][m][1]); }
            }
        } else {
            bf16_t* dst = GLU + (size_t)(u.pm * BM + wr * 64 + fr) * CW + (pn - 12) * 128 + wc * 32 + fq * 8;
#pragma unroll
            for (int ai = 0; ai < 2; ++ai)
#pragma unroll
                for (int m = 0; m < 4; ++m) {
                    f32x4 v0 = acc[ai][0][m][0], v1 = acc[ai][0][m][1]; const f32x4 g0 = acc[ai][1][m][0], g1 = acc[ai][1][m][1];
#pragma unroll
                    for (int e = 0; e < 4; ++e) { v0[e] *= sigmoid_fast(g0[e]); v1[e] *= sigmoid_fast(g1[e]); }
                    *(u32x4*)(dst + (size_t)(ai * 128 + m * 16) * CW) = pack8(v0, v1);
                }
        }
    }
};
template <bool BASE_BF16>
struct EpiRes {
    static constexpr bool PERM = true, AFTER_DRAIN = false;
    const void* base; bf16_t* outb; const float* gate;
    __device__ __forceinline__ void operator()(const f32x4 (&acc)[2][2][4][2], const Unit& u, int wr, int wc, int fr, int fq) const {
        const int b = u.pm >> 3, col0 = u.pn * BM + wc * 32 + fq * 8;
        f32x4 gv[2][2];
#pragma unroll
        for (int bj = 0; bj < 2; ++bj)
#pragma unroll
            for (int n = 0; n < 2; ++n) gv[bj][n] = *(const f32x4*)(gate + (size_t)b * NMODC + col0 + bj * HALF + n * 4);
#pragma unroll
        for (int ai = 0; ai < 2; ++ai)
#pragma unroll
            for (int m = 0; m < 4; ++m) { const size_t off = (size_t)(u.pm * BM + ai * HALF + wr * 64 + m * 16 + fr) * DM + col0;
                f32x4 x[2][2];
#pragma unroll
                for (int bj = 0; bj < 2; ++bj) {
                    if (BASE_BF16) { const u32x4 w = *(const u32x4*)((const bf16_t*)base + off + bj * HALF);
                        x[bj][0] = (f32x4){__uint_as_float(w.x << 16), __uint_as_float(w.x & 0xffff0000u), __uint_as_float(w.y << 16), __uint_as_float(w.y & 0xffff0000u)};
                        x[bj][1] = (f32x4){__uint_as_float(w.z << 16), __uint_as_float(w.z & 0xffff0000u), __uint_as_float(w.w << 16), __uint_as_float(w.w & 0xffff0000u)}; }
                    else { x[bj][0] = *(const f32x4*)((const float*)base + off + bj * HALF); x[bj][1] = *(const f32x4*)((const float*)base + off + bj * HALF + 4); } }
#pragma unroll
                for (int bj = 0; bj < 2; ++bj) *(u32x4*)(outb + off + bj * HALF) = pack8(x[bj][0] + gv[bj][0] * acc[ai][bj][m][0], x[bj][1] + gv[bj][1] * acc[ai][bj][m][1]);
                asm volatile("" ::: "memory"); }
    }
};
struct EpiGU {
    static constexpr bool PERM = true, AFTER_DRAIN = false;
    bf16_t* ACT;
    __device__ __forceinline__ void operator()(const f32x4 (&acc)[2][2][4][2], const Unit& u, int wr, int wc, int fr, int fq) const {
        bf16_t* dst = ACT + (size_t)(u.pm * BM + wr * 64 + fr) * DFF + u.pn * 128 + wc * 32 + fq * 8;
#pragma unroll
        for (int ai = 0; ai < 2; ++ai)
#pragma unroll
            for (int m = 0; m < 4; ++m) {
                const f32x4 g0 = acc[ai][0][m][0], g1 = acc[ai][0][m][1];
                f32x4 t0 = g0 * -1.4426950408889634f, t1 = g1 * -1.4426950408889634f;
#pragma unroll
                for (int e = 0; e < 4; ++e) { t0[e] = __builtin_amdgcn_exp2f(t0[e]); t1[e] = __builtin_amdgcn_exp2f(t1[e]); }
                t0 = t0 + 1.0f; t1 = t1 + 1.0f;
#pragma unroll
                for (int e = 0; e < 4; ++e) { t0[e] = __builtin_amdgcn_rcpf(t0[e]); t1[e] = __builtin_amdgcn_rcpf(t1[e]); }
                const f32x4 v0 = (acc[ai][1][m][0] * g0) * t0, v1 = (acc[ai][1][m][1] * g1) * t1;
                __builtin_nontemporal_store(pack8(v0, v1), (u32x4*)(dst + (size_t)(ai * 128 + m * 16) * DFF));
            }
    }
};

template <class Epi, class Sched, bool ALIGN_EPI = false, bool SP2 = false>
__device__ __forceinline__ void gemm_phase(PG8_LAS unsigned char* lds, const Gemm g, const Sched& S, const Epi& E) {
    const int tid = threadIdx.x, wid = __builtin_amdgcn_readfirstlane(tid >> 6), lane = tid & 63, wr = wid >> 2, wc = wid & 3, fr = lane & 15, fq = lane >> 4;
    const int K = g.K, nt = K / BK;
    unsigned voffA[2], voffB[2];
#pragma unroll
    for (int i = 0; i < 2; ++i) { int R, C; stage_rc(tid * 16 + i * 8192, R, C); const int Rb = Epi::PERM ? ((R & ~31) + perm32(R & 31)) : R;
        voffA[i] = (unsigned)(R * K + C) * 2u; voffB[i] = (unsigned)(Rb * K + C) * 2u; }
    const size_t kstep = (size_t)(BK * 2);
    const size_t hstep = (size_t)HALF * K * 2;
    const size_t tstep = 2 * hstep;
    const unsigned ldsw = (unsigned)wid * 1024u;
    const int aoff = lds_byte(wr * 64 + fr, fq * 8), boff = lds_byte(wc * 32 + fr, fq * 8);
#define PG8_SA(b, h) (((b) * 2 + (h)) * HTB)
#define PG8_SB(b, h) ((4 + (b) * 2 + (h)) * HTB)
#define PG8_STAGE(bufoff, gbase, voff) do { _Pragma("unroll") for (int _i = 0; _i < 2; ++_i) \
        __builtin_amdgcn_global_load_lds((const unsigned*)((const char*)(gbase) + (voff)[_i]), (PG8_LAS unsigned*)(lds + (bufoff) + ldsw + _i * 8192), 16, 0, 0); } while (0)
#define PG8_LDA(dst, b, h) do { _Pragma("unroll") for (int m = 0; m < 4; ++m) _Pragma("unroll") for (int k = 0; k < 2; ++k) dst[m][k] = *(const PG8_LAS bf16x8*)(lds + PG8_SA(b, h) + aoff + m * 2048 + k * 1024); } while (0)
#define PG8_LDB(dst, b, h) do { _Pragma("unroll") for (int n = 0; n < 2; ++n) _Pragma("unroll") for (int k = 0; k < 2; ++k) dst[n][k] = *(const PG8_LAS bf16x8*)(lds + PG8_SB(b, h) + boff + n * 2048 + k * 1024); } while (0)
#define PG8_MMA(ai, bj, At, Bt) do { __builtin_amdgcn_s_setprio(1); _Pragma("unroll") for (int m = 0; m < 4; ++m) _Pragma("unroll") for (int n = 0; n < 2; ++n) _Pragma("unroll") for (int k = 0; k < 2; ++k) \
        acc[ai][bj][m][n] = __builtin_amdgcn_mfma_f32_16x16x32_bf16(Bt[n][k], At[m][k], acc[ai][bj][m][n], 0, 0, 0); __builtin_amdgcn_s_setprio(0); } while (0)
#define PG8_WAIT_V(n) asm volatile("s_waitcnt vmcnt(" #n ")" ::: "memory")
#define PG8_WAIT_L(n) asm volatile("s_waitcnt lgkmcnt(" #n ")" ::: "memory")
#define PG8_BAR __builtin_amdgcn_s_barrier()
#define PG8_SCHED __builtin_amdgcn_sched_barrier(0)
    Unit cur, nxt; int ui = 0;
    if (!S.next(0, cur)) return;
    f32x4 acc[2][2][4][2];
#pragma unroll
    for (int a = 0; a < 2; ++a)
#pragma unroll
        for (int b = 0; b < 2; ++b)
#pragma unroll
            for (int m = 0; m < 4; ++m)
#pragma unroll
                for (int n = 0; n < 2; ++n) acc[a][b][m][n] = (f32x4){0.f, 0.f, 0.f, 0.f};
    bf16x8 At[4][2], B0[2][2], B1[2][2];
    const char* cA = (const char*)g.A + (size_t)cur.pm * tstep; const char* cB = (const char*)g.Bt + (size_t)cur.pn * tstep;
    S.a_ready(cur);
    if constexpr (SP2) {
        PG8_STAGE(PG8_SB(0, 0), cB, voffB); PG8_STAGE(PG8_SB(0, 1), cB + hstep, voffB); PG8_STAGE(PG8_SA(0, 0), cA, voffA); PG8_STAGE(PG8_SA(0, 1), cA + hstep, voffA);
        if (wr == 1) PG8_BAR;
        PG8_WAIT_V(2); PG8_BAR;
        PG8_STAGE(PG8_SB(1, 0), cB + kstep, voffB); PG8_STAGE(PG8_SA(1, 0), cA + kstep, voffA); PG8_STAGE(PG8_SB(1, 1), cB + hstep + kstep, voffB);
        PG8_WAIT_V(6); PG8_BAR;
    } else {
        PG8_STAGE(PG8_SB(0, 0), cB, voffB); PG8_STAGE(PG8_SA(0, 0), cA, voffA); PG8_STAGE(PG8_SB(0, 1), cB + hstep, voffB); PG8_STAGE(PG8_SA(0, 1), cA + hstep, voffA);
        if (wr == 1) PG8_BAR;
        PG8_WAIT_V(4); PG8_BAR;
        PG8_STAGE(PG8_SB(1, 0), cB + kstep, voffB); PG8_STAGE(PG8_SA(1, 0), cA + kstep, voffA); PG8_STAGE(PG8_SB(1, 1), cB + hstep + kstep, voffB);
        PG8_WAIT_V(6); PG8_BAR;
    }
    for (;;) {
        const bool has_next = S.next(ui + 1, nxt);
        const char* nA = has_next ? (const char*)g.A + (size_t)nxt.pm * tstep : cA; const char* nB = has_next ? (const char*)g.Bt + (size_t)nxt.pn * tstep : cB;
        for (int t = 0; t < nt; t += 2) {
            const bool last = (t == nt - 2);
            const char* a1 = cA + (size_t)(t + 1) * kstep;
            const char* a2 = last ? nA : cA + (size_t)(t + 2) * kstep; const char* b2 = last ? nB : cB + (size_t)(t + 2) * kstep;
            const char* a3 = a2 + kstep; const char* b3 = b2 + kstep;
            if (last && has_next) S.a_ready(nxt);
            if constexpr (SP2) {
            PG8_LDB(B0, 0, 0); PG8_LDB(B1, 0, 1); PG8_SCHED; PG8_LDA(At, 0, 0); PG8_STAGE(PG8_SA(1, 1), a1 + hstep, voffA);
            PG8_WAIT_V(8); PG8_WAIT_L(0); PG8_BAR; PG8_MMA(0, 0, At, B0); PG8_MMA(0, 1, At, B1); PG8_BAR; PG8_SCHED;
            PG8_LDA(At, 0, 1); PG8_STAGE(PG8_SB(0, 0), b2, voffB); PG8_STAGE(PG8_SB(0, 1), b2 + hstep, voffB); PG8_STAGE(PG8_SA(0, 0), a2, voffA);
            PG8_WAIT_V(8); PG8_WAIT_L(0); PG8_BAR; PG8_MMA(1, 0, At, B0); PG8_MMA(1, 1, At, B1); PG8_BAR; PG8_SCHED;
            PG8_LDB(B0, 1, 0); PG8_LDB(B1, 1, 1); PG8_SCHED; PG8_LDA(At, 1, 0); PG8_STAGE(PG8_SA(0, 1), a2 + hstep, voffA);
            PG8_WAIT_V(8); PG8_WAIT_L(0); PG8_BAR; PG8_MMA(0, 0, At, B0); PG8_MMA(0, 1, At, B1); PG8_BAR; PG8_SCHED;
            PG8_LDA(At, 1, 1); PG8_STAGE(PG8_SB(1, 0), b3, voffB); PG8_STAGE(PG8_SB(1, 1), b3 + hstep, voffB); PG8_STAGE(PG8_SA(1, 0), a3, voffA);
            PG8_WAIT_V(8); PG8_WAIT_L(0); PG8_BAR; PG8_MMA(1, 0, At, B0); PG8_MMA(1, 1, At, B1); PG8_BAR; PG8_SCHED;
            } else {
            PG8_LDB(B0, 0, 0); PG8_SCHED; PG8_LDA(At, 0, 0); PG8_STAGE(PG8_SA(1, 1), a1 + hstep, voffA);
            PG8_WAIT_L(8); PG8_BAR; PG8_WAIT_L(0); PG8_MMA(0, 0, At, B0); PG8_BAR; PG8_SCHED;
            PG8_LDB(B1, 0, 1); PG8_STAGE(PG8_SB(0, 0), b2, voffB);
            PG8_BAR; PG8_WAIT_L(0); PG8_MMA(0, 1, At, B1); PG8_BAR;
            PG8_LDA(At, 0, 1); PG8_STAGE(PG8_SA(0, 0), a2, voffA);
            PG8_BAR; PG8_WAIT_L(0); PG8_MMA(1, 0, At, B0); PG8_BAR; PG8_SCHED;
            PG8_STAGE(PG8_SB(0, 1), b2 + hstep, voffB);
            PG8_WAIT_V(6); PG8_BAR; PG8_MMA(1, 1, At, B1); PG8_BAR;
            PG8_LDB(B0, 1, 0); PG8_SCHED; PG8_LDA(At, 1, 0); PG8_STAGE(PG8_SA(0, 1), a2 + hstep, voffA);
            PG8_WAIT_L(8); PG8_BAR; PG8_WAIT_L(0); PG8_MMA(0, 0, At, B0); PG8_BAR; PG8_SCHED;
            PG8_LDB(B1, 1, 1); PG8_STAGE(PG8_SB(1, 0), b3, voffB);
            PG8_BAR; PG8_WAIT_L(0); PG8_MMA(0, 1, At, B1); PG8_BAR;
            PG8_LDA(At, 1, 1); PG8_STAGE(PG8_SA(1, 0), a3, voffA);
            PG8_BAR; PG8_WAIT_L(0); PG8_MMA(1, 0, At, B0); PG8_BAR; PG8_SCHED;
            PG8_STAGE(PG8_SB(1, 1), b3 + hstep, voffB);
            PG8_WAIT_V(6); PG8_BAR; PG8_MMA(1, 1, At, B1); PG8_BAR;
            }
        }
        if constexpr (ALIGN_EPI) { if (wr == 0) PG8_BAR; }
        if constexpr (!Epi::AFTER_DRAIN) { E(acc, cur, wr, wc, fr, fq); S.done(cur); }
        if (!has_next) break;
#pragma unroll
        for (int a = 0; a < 2; ++a)
#pragma unroll
            for (int b = 0; b < 2; ++b)
#pragma unroll
                for (int m = 0; m < 4; ++m)
#pragma unroll
                    for (int n = 0; n < 2; ++n) acc[a][b][m][n] = (f32x4){0.f, 0.f, 0.f, 0.f};
        cur = nxt; cA = nA; cB = nB; ++ui;
        if constexpr (ALIGN_EPI) { if (wr == 1) PG8_BAR; }
    }
    PG8_WAIT_V(0);
    if constexpr (!ALIGN_EPI) { if (wr == 0) PG8_BAR; }
    PG8_BAR;
    if constexpr (Epi::AFTER_DRAIN) { E.fused(acc, cur, wr, wc, fr, fq, lds, wid, lane); S.done(cur); }
#undef PG8_SA
#undef PG8_SB
#undef PG8_STAGE
#undef PG8_LDA
#undef PG8_LDB
#undef PG8_MMA
#undef PG8_WAIT_V
#undef PG8_WAIT_L
#undef PG8_BAR
#undef PG8_SCHED
}
}
namespace att {
typedef unsigned short bf16;
typedef short bf16x8 __attribute__((ext_vector_type(8)));
typedef short s16x4 __attribute__((ext_vector_type(4)));
typedef float f32x16 __attribute__((ext_vector_type(16)));
typedef float f32x4 __attribute__((ext_vector_type(4)));
typedef unsigned u32x4 __attribute__((ext_vector_type(4)));
template <class A, class Bt> struct same_t { static constexpr bool v = false; };
template <class A> struct same_t<A, A> { static constexpr bool v = true; };
constexpr float SCALE = 0.08838834764831845f;
constexpr float THR = 8.f;
constexpr int NW = 8, QBLK = 32, KVBLK = 64, QB = NW * QBLK, D = 128, LDO = 2048;
constexpr int SHM_V = KVBLK * D * 2, SHM_K = KVBLK * D * 2;
constexpr int LDS_BYTES = 2 * SHM_V + 2 * SHM_K + NW * 64 * 4;
#define KSWZ(row, colB) ((row) * 256 + ((colB) ^ (((row) & 7) << 4)))
#define SBAR() __builtin_amdgcn_sched_barrier(0)
__device__ __forceinline__ int v_st(int k, int c) { const int kk = (k & ~0xC) | ((k & 4) << 1) | ((k & 8) >> 1); return ((kk >> 3) * 4 + (c >> 5)) * 512 + ((kk & 7) * 32 + (c & 31)) * 2; }
__device__ __forceinline__ int v_rd_base(int lane) { return ((lane & 3) << 3) | (((lane >> 2) & 3) << 6) | (((lane >> 4) & 1) << 5) | (((lane >> 5) & 1) << 8); }
constexpr int v_rd_off(int d0, int ks, int half) { return d0 * 512 + ks * 4096 + half * 2048; }
__device__ __forceinline__ int crow(int r, int hi) { return (r & 3) + 8 * (r >> 2) + 4 * hi; }
__device__ __forceinline__ unsigned cvtpk(float lo, float hi) {
    unsigned r; asm volatile("v_cvt_pk_bf16_f32 %0, %1, %2" : "=v"(r) : "v"(lo), "v"(hi)); return r;
}
__device__ __forceinline__ bf16x8 pack8(f32x4 a, f32x4 b) {
    u32x4 w = {cvtpk(a[0], a[1]), cvtpk(a[2], a[3]), cvtpk(b[0], b[1]), cvtpk(b[2], b[3])};
    return *reinterpret_cast<bf16x8*>(&w);
}
template <class T> __device__ __forceinline__ bf16x8 load8(const T* p) {
    if constexpr (same_t<T, float>::v) { return pack8(*(const f32x4*)p, *(const f32x4*)(p + 4)); }
    else { return *reinterpret_cast<const bf16x8*>(p); }
}
__device__ __forceinline__ void mask_tile(f32x16& p0, f32x16& p1, int dq, unsigned W) {
    const float NEG = -__builtin_inff();
#pragma unroll
    for (int r = 0; r < 16; ++r) {
        const int c = (r & 3) + 8 * (r >> 2);
        if ((unsigned)(dq - c) >= W) p0[r] = NEG;
        if ((unsigned)(dq - c - 32) >= W) p1[r] = NEG;
    }
}
__device__ __forceinline__ void partialSM(f32x16& p0, f32x16& p1, float& m_reg, float& mn, float& alpha, const bool keep = true) {
    float pmax = p0[0]; for (int r = 1; r < 16; ++r) pmax = fmaxf(pmax, p0[r]); for (int r = 0; r < 16; ++r) pmax = fmaxf(pmax, p1[r]);
    { auto rr = __builtin_amdgcn_permlane32_swap(__float_as_uint(pmax), __float_as_uint(pmax), false, false);
      pmax = fmaxf(__uint_as_float(rr[0]), __uint_as_float(rr[1])); }
    pmax = keep ? pmax : -__builtin_inff();
    constexpr float C2 = 1.4426950408889634f * SCALE;
    if (__builtin_expect(__all((pmax - m_reg) * SCALE <= THR), 1)) { mn = m_reg; alpha = 1.f; }
    else { mn = fmaxf(m_reg, pmax); alpha = __builtin_amdgcn_exp2f((m_reg - mn) * C2); m_reg = mn; }
    const float mnL = keep ? -mn * C2 : -__builtin_inff();
    p0 = p0 * C2 + mnL; p1 = p1 * C2 + mnL;
    for (int r = 0; r < 16; ++r) p0[r] = __builtin_amdgcn_exp2f(p0[r]);
}
__device__ __forceinline__ void finishSM(f32x16& p0, f32x16& p1, float alpha, float& l_reg, bf16x8& pa0, bf16x8& pa1, bf16x8& pa2, bf16x8& pa3) {
    for (int r = 0; r < 16; ++r) p1[r] = __builtin_amdgcn_exp2f(p1[r]);
    float ps;
    { typedef float f32x8_ __attribute__((ext_vector_type(8))); typedef float f32x2_ __attribute__((ext_vector_type(2)));
      f32x8_ s8 = p0.lo + p0.hi; s8 += p1.lo; s8 += p1.hi; const f32x4 s4 = s8.lo + s8.hi; const f32x2_ s2 = s4.lo + s4.hi; ps = s2.x + s2.y; }
    { auto rr = __builtin_amdgcn_permlane32_swap(__float_as_uint(ps), __float_as_uint(ps), false, false);
      ps = __uint_as_float(rr[0]) + __uint_as_float(rr[1]); }
    l_reg = l_reg * alpha + ps;
#define PK4(P, B_, OUT) do { unsigned a0 = cvtpk(P[B_+0], P[B_+1]), a1 = cvtpk(P[B_+2], P[B_+3]);                          \
        unsigned b0 = cvtpk(P[B_+4], P[B_+5]), b1 = cvtpk(P[B_+6], P[B_+7]);                                             \
        auto r0 = __builtin_amdgcn_permlane32_swap(a0, b0, false, false); auto r1 = __builtin_amdgcn_permlane32_swap(a1, b1, false, false); \
        u32x4 w = {r0[0], r1[0], r0[1], r1[1]}; OUT = *reinterpret_cast<bf16x8*>(&w); } while (0)
    PK4(p0, 0, pa0); PK4(p0, 8, pa1); PK4(p1, 0, pa2); PK4(p1, 8, pa3);
#undef PK4
}
template <int KB, bool SK>
__device__ __forceinline__ void qkt(f32x16& p0, f32x16& p1, const char* K_lds, int r32, int hi, const bf16x8* qr, bool act) {
    if (SK && !act) { const float NEG = -__builtin_inff();
#pragma unroll
        for (int r = 0; r < 16; ++r) { p0[r] = NEG; p1[r] = NEG; } return; }
    p0 = f32x16{}; p1 = f32x16{};
    const char* kb[4];
#pragma unroll
    for (int dd = 0; dd < 4; ++dd) kb[dd] = K_lds + KB * SHM_K + KSWZ(r32, (dd * 16 + hi * 8) * 2);
#pragma unroll
    for (int d0 = 0; d0 < 8; ++d0) { const char* a = kb[d0 & 3] + (d0 >> 2) * 128;
        bf16x8 b0 = *reinterpret_cast<const bf16x8*>(a);
        bf16x8 b1 = *reinterpret_cast<const bf16x8*>(a + 32 * 256);
        p0 = __builtin_amdgcn_mfma_f32_32x32x16_bf16(b0, qr[d0], p0, 0, 0, 0);
        p1 = __builtin_amdgcn_mfma_f32_32x32x16_bf16(b1, qr[d0], p1, 0, 0, 0); }
}
template <int VB, bool SK>
__device__ __forceinline__ void pv_tile(f32x16* o, int vb0, bf16x8 pa0, bf16x8 pa1, bf16x8 pa2, bf16x8 pa3, bool act) {
    if (SK && !act) return;
#define TRRD(dst, off) asm volatile("ds_read_b64_tr_b16 %0, %1 offset:%2" : "=&v"(dst) : "v"(vb0), "i"(off) : "memory")
#define PV_LD(S, d0) do { constexpr int b_ = VB * SHM_V + v_rd_off(d0, 0, 0); \
        TRRD(S##l0, b_); TRRD(S##h0, b_ + 2048); TRRD(S##l1, b_ + 4096); TRRD(S##h1, b_ + 6144); TRRD(S##l2, b_ + 8192); TRRD(S##h2, b_ + 10240); TRRD(S##l3, b_ + 12288); TRRD(S##h3, b_ + 14336); } while (0)
#define PV_MM(S, d0) do { \
        o[d0] = __builtin_amdgcn_mfma_f32_32x32x16_bf16(pa0, (bf16x8){S##l0[0], S##l0[1], S##l0[2], S##l0[3], S##h0[0], S##h0[1], S##h0[2], S##h0[3]}, o[d0], 0, 0, 0);   \
        o[d0] = __builtin_amdgcn_mfma_f32_32x32x16_bf16(pa1, (bf16x8){S##l1[0], S##l1[1], S##l1[2], S##l1[3], S##h1[0], S##h1[1], S##h1[2], S##h1[3]}, o[d0], 0, 0, 0);   \
        o[d0] = __builtin_amdgcn_mfma_f32_32x32x16_bf16(pa2, (bf16x8){S##l2[0], S##l2[1], S##l2[2], S##l2[3], S##h2[0], S##h2[1], S##h2[2], S##h2[3]}, o[d0], 0, 0, 0);   \
        o[d0] = __builtin_amdgcn_mfma_f32_32x32x16_bf16(pa3, (bf16x8){S##l3[0], S##l3[1], S##l3[2], S##l3[3], S##h3[0], S##h3[1], S##h3[2], S##h3[3]}, o[d0], 0, 0, 0); } while (0)
    s16x4 Al0, Al1, Al2, Al3, Ah0, Ah1, Ah2, Ah3, Bl0, Bl1, Bl2, Bl3, Bh0, Bh1, Bh2, Bh3;
    PV_LD(A, 0);
    PV_LD(B, 1); asm volatile("s_waitcnt lgkmcnt(8)" ::: "memory"); SBAR(); PV_MM(A, 0); SBAR();
    PV_LD(A, 2); asm volatile("s_waitcnt lgkmcnt(8)" ::: "memory"); SBAR(); PV_MM(B, 1); SBAR();
    PV_LD(B, 3); asm volatile("s_waitcnt lgkmcnt(8)" ::: "memory"); SBAR(); PV_MM(A, 2); SBAR();
    asm volatile("s_waitcnt lgkmcnt(0)" ::: "memory"); SBAR(); PV_MM(B, 3);
#undef PV_LD
#undef PV_MM
#undef TRRD
}
__device__ __forceinline__ void sel_mask(f32x16& p0, f32x16& p1, bool keep) {
    const float NEG = -__builtin_inff();
#pragma unroll
    for (int r = 0; r < 16; ++r) { p0[r] = keep ? p0[r] : NEG; p1[r] = keep ? p1[r] : NEG; }
}
struct BlockRef { int bh; int blk; };
struct Tensors { const bf16* Q; const bf16* K; bf16* O; const float* KS; };
constexpr size_t VOFF = (size_t)64 * 1024 * 1024 / 2;
constexpr int KS_OFF = LDS_BYTES;
#define BR_Q(r) (T.Q + ((size_t)(r).bh * 2048 + (r).blk * 256) * D)
#define BR_K(r) (T.K + (size_t)(r).bh * 2048 * D)
#define BR_V(r) (T.K + VOFF + (size_t)(r).bh * 2048 * D)
#define BR_O(r) (T.O + ((size_t)((r).bh >> 3) * 2048 + (r).blk * 256) * LDO + ((r).bh & 7) * D)
#define BR_KS(r) (T.KS + (size_t)(r).bh * 8 * D)
struct Seam { bf16x8 qr[8]; bf16x8 st_v0, st_v1, st_k0, st_k1; };
#define ROW(p, k0, rr) ((p) + (size_t)((k0) + (rr)) * D + sc)
#define VMW() asm volatile("s_waitcnt vmcnt(0)" ::: "memory")
#define VMWN(n) asm volatile("s_waitcnt vmcnt(%0)" :: "i"(n) : "memory")
#define SLOAD_H(Kp, Vp, k0) do { unsigned lo__ = loff; asm volatile("" : "+v"(lo__)); const char* kb__ = (const char*)(Kp) + (size_t)(k0) * (D * 2); const char* vb__ = (const char*)(Vp) + (size_t)(k0) * (D * 2);   \
                         S.st_v0 = *(const bf16x8*)(vb__ + lo__); S.st_v1 = *(const bf16x8*)(vb__ + lo__ + 32 * D * 2);              \
                         S.st_k0 = *(const bf16x8*)(kb__ + lo__); S.st_k1 = *(const bf16x8*)(kb__ + lo__ + 32 * D * 2); } while (0)
#define SWRITE_HK(bf) do { *(bf16x8*)(K_lds + (bf) * SHM_K + kws) = S.st_k0; *(bf16x8*)(K_lds + (bf) * SHM_K + kws + 32 * 256) = S.st_k1; } while (0)
#define SWRITE_HV(bf) do { *(bf16x8*)(V_lds + (bf) * SHM_V + vst0) = S.st_v0; *(bf16x8*)(V_lds + (bf) * SHM_V + vst1) = S.st_v1; } while (0)
#define SWRITE_H(bf) do { SWRITE_HV(bf); SWRITE_HK(bf); } while (0)
__device__ __forceinline__ void moba_prime(const Tensors& T, const BlockRef& cur, char* lds, Seam& S) {
    const int tid = threadIdx.x, wid = __builtin_amdgcn_readfirstlane(tid >> 6), lane = tid & 63, r32 = lane & 31, hi = lane >> 5;
    const int sr = tid >> 4, sc = (tid & 15) * 8, kws = KSWZ(sr, sc * 2); char* K_lds = lds + 2 * SHM_V; const unsigned loff = (unsigned)(sr * D + sc) * 2u;
#pragma unroll
    for (int d0 = 0; d0 < 8; ++d0) S.qr[d0] = load8<bf16>(BR_Q(cur) + (size_t)(wid * QBLK + r32) * D + d0 * 16 + hi * 8);
    SLOAD_H(BR_K(cur), BR_V(cur), 0);
    if (tid < 256) { const f32x4 v = *(const f32x4*)(BR_KS(cur) + tid * 4); *(f32x4*)(lds + KS_OFF + tid * 16) = v; }
    VMW(); SWRITE_HK(0);
    __syncthreads();
}
__device__ __forceinline__ void moba_block(const Tensors& T, const BlockRef& cur, const BlockRef& nxt, char* lds, Seam& S) {
    const int tid = threadIdx.x, wid = __builtin_amdgcn_readfirstlane(tid >> 6), lane = tid & 63, r32 = lane & 31, hi = lane >> 5;
    const int blk = cur.blk, P0 = blk * QB;
    const int NT = (P0 + QB) / KVBLK;
    const int qlo = P0 + wid * QBLK, qm = qlo + r32 - 4 * hi;
    char* V_lds = lds; char* K_lds = lds + 2 * SHM_V;
    float* ws = (float*)(lds + 2 * SHM_V + 2 * SHM_K) + wid * 64; float* li_l = ws, * al_l = ws + 32;
    float m_reg = -1e30f, l_reg = 0;
    const int sr = tid >> 4, sc = (tid & 15) * 8, vst0 = v_st(sr, sc), vst1 = v_st(32 + sr, sc), kws = KSWZ(sr, sc * 2); const unsigned loff = (unsigned)(sr * D + sc) * 2u;
    const int vb0 = (int)(uintptr_t)V_lds + v_rd_base(lane);
    const bf16* Kh = BR_K(cur); const bf16* Vh = Kh + VOFF;
    unsigned sel = (1u << blk) - 1u;
#ifndef NO_GATE
    if (blk > 3) {
        float qf[64];
#pragma unroll
        for (int d0 = 0; d0 < 8; ++d0)
#pragma unroll
            for (int e = 0; e < 8; ++e) qf[d0 * 8 + e] = __uint_as_float(((unsigned)(unsigned short)S.qr[d0][e]) << 16);
        float b0 = -__builtin_inff(), b1 = b0, b2 = b0; unsigned i0 = 0u, i1 = 0u, i2 = 0u;
#pragma unroll 1
        for (int n = 0; n < blk; ++n) {
            const float* kp = (const float*)(lds + KS_OFF) + n * 128 + hi * 8;
            float g = 0.f;
#pragma unroll
            for (int d0 = 0; d0 < 8; ++d0) { const f32x4 a = *(const f32x4*)(kp + d0 * 16), b = *(const f32x4*)(kp + d0 * 16 + 4);
                g += (qf[d0 * 8 + 0] * a[0] + qf[d0 * 8 + 1] * a[1]) + (qf[d0 * 8 + 2] * a[2] + qf[d0 * 8 + 3] * a[3]) + (qf[d0 * 8 + 4] * b[0] + qf[d0 * 8 + 5] * b[1]) + (qf[d0 * 8 + 6] * b[2] + qf[d0 * 8 + 7] * b[3]); }
            { auto rr = __builtin_amdgcn_permlane32_swap(__float_as_uint(g), __float_as_uint(g), false, false); g = __uint_as_float(rr[0]) + __uint_as_float(rr[1]); }
            const unsigned bit = 1u << n;
            const bool c0 = g > b0, c1 = g > b1, c2 = g > b2;
            b2 = c1 ? b1 : (c2 ? g : b2); i2 = c1 ? i1 : (c2 ? bit : i2);
            b1 = c0 ? b0 : (c1 ? g : b1); i1 = c0 ? i0 : (c1 ? bit : i1);
            b0 = c0 ? g : b0;             i0 = c0 ? bit : i0;
        }
        sel = i0 | i1 | i2;
    }
#endif
    f32x16 o[4] = {};
#define RESC(a) do { if (__any((a) < 1.f)) { if (hi == 0) al_l[r32] = (a); asm volatile("s_waitcnt lgkmcnt(0)" ::: "memory");              \
                     for (int d_ = 0; d_ < 4; ++d_) for (int r = 0; r < 16; ++r) o[d_][r] *= al_l[crow(r, hi)]; } } while (0)
#define KBASE(t) ((t) * KVBLK)
#define MASKT(P0_, P1_, t) do { const int kb_ = KBASE(t); \
        if (kb_ >= P0) { if (kb_ + KVBLK - 1 > qlo) mask_tile(P0_, P1_, qm - kb_, 0x7fffffffu); } } while (0)
#define KEEPT(t) ((KBASE(t) >= P0) || (((sel >> ((t) >> 2)) & 1u) != 0u))
    constexpr int NQL = 8;
    constexpr bool SK = false;
#define SEAM_K0() do { VMWN(NQL); SWRITE_HK(0); SBAR(); } while (0)
    f32x16 pA0, pA1, pB0, pB1; float mnA, mnB, alA, alB; bf16x8 pa0, pa1, pa2, pa3;
    SWRITE_HV(0); SBAR();
    SLOAD_H(Kh, Vh, KBASE(1));
    SBAR(); qkt<0, SK>(pA0, pA1, K_lds, r32, hi, S.qr, true);
    MASKT(pA0, pA1, 0); partialSM(pA0, pA1, m_reg, mnA, alA, KEEPT(0));
    VMW(); SWRITE_H(1);
    __syncthreads();
#define HALF_STEP(PX0, PX1, mnX, alX, PY0, PY1, alY, t, KB, VB, SB) do {                                                      \
        SBAR(); if ((t) + 1 < NT) { SLOAD_H(Kh, Vh, KBASE((t) + 1)); SBAR(); }                                                \
        qkt<KB, SK>(PX0, PX1, K_lds, r32, hi, S.qr, true);                                                                    \
        finishSM(PY0, PY1, alY, l_reg, pa0, pa1, pa2, pa3); SBAR();                                                           \
        pv_tile<VB, SK>(o, vb0, pa0, pa1, pa2, pa3, true); MASKT(PX0, PX1, (t)); partialSM(PX0, PX1, m_reg, mnX, alX, KEEPT(t));        \
        __syncthreads();                                                                                                      \
        if ((t) + 1 < NT) { VMW(); SWRITE_H(SB); }                                                                            \
        RESC(alX); __syncthreads(); } while (0)
    for (int t = 1; t + 1 < NT; t += 2) {
        HALF_STEP(pB0, pB1, mnB, alB, pA0, pA1, alA, t, 1, 0, 0);
        HALF_STEP(pA0, pA1, mnA, alA, pB0, pB1, alB, t + 1, 0, 1, 1);
    }
    { SBAR(); qkt<1, SK>(pB0, pB1, K_lds, r32, hi, S.qr, true); SBAR(); }
    SLOAD_H(BR_K(nxt), BR_V(nxt), 0); SBAR();
    { unsigned qo__ = (unsigned)((wid * QBLK + r32) * D + hi * 8) * 2u; asm volatile("" : "+v"(qo__)); const char* qb__ = (const char*)BR_Q(nxt) + qo__;
#pragma unroll
      for (int d0 = 0; d0 < 8; ++d0) S.qr[d0] = *(const bf16x8*)(qb__ + d0 * 32); }
    SBAR();
    finishSM(pA0, pA1, alA, l_reg, pa0, pa1, pa2, pa3); SBAR();
    pv_tile<0, SK>(o, vb0, pa0, pa1, pa2, pa3, true);
    { MASKT(pB0, pB1, NT - 1); partialSM(pB0, pB1, m_reg, mnB, alB, KEEPT(NT - 1)); __syncthreads(); RESC(alB);
      finishSM(pB0, pB1, alB, l_reg, pa0, pa1, pa2, pa3); SBAR(); pv_tile<1, SK>(o, vb0, pa0, pa1, pa2, pa3, true); }
    SBAR(); SEAM_K0();
    if (hi == 0) li_l[r32] = l_reg; asm volatile("s_waitcnt lgkmcnt(0)" ::: "memory");
    float rli[16];
#pragma unroll
    for (int r = 0; r < 16; ++r) rli[r] = __builtin_amdgcn_rcpf(li_l[crow(r, hi)]);
    char* Ow = (char*)(BR_O(cur) + (size_t)(wid * QBLK) * LDO);
    unsigned oo__ = (unsigned)(4 * hi * LDO + r32) * 2u; asm volatile("" : "+v"(oo__));
#pragma unroll
    for (int r = 0; r < 16; ++r) { const int orow0 = (r & 3) + 8 * (r >> 2);
#pragma unroll
        for (int d0 = 0; d0 < 4; ++d0) { const float v = o[d0][r] * rli[r];
            const float vn = __shfl_xor(v, 1);
            if ((r32 & 1) == 0) *(unsigned*)(Ow + (size_t)(orow0 * LDO + d0 * 32) * 2 + oo__) = cvtpk(v, vn); } }
    if (tid < 256) { unsigned ko__ = (unsigned)tid * 16u; asm volatile("" : "+v"(ko__)); const f32x4 v = *(const f32x4*)((const char*)BR_KS(nxt) + ko__); *(f32x4*)(lds + KS_OFF + tid * 16) = v; }
    __syncthreads();
#undef RESC
#undef KBASE
#undef MASKT
#undef KEEPT
#undef SEAM_K0
#undef HALF_STEP
}
#undef ROW
#undef BR_Q
#undef BR_K
#undef BR_V
#undef BR_O
#undef BR_KS
#undef VMW
#undef VMWN
#undef SLOAD_H
#undef SWRITE_HK
#undef SWRITE_HV
#undef SWRITE_H
#undef SBAR
#undef KSWZ
}

#define LAS __attribute__((address_space(3)))
typedef unsigned short bf16_t;
typedef float f32x4 __attribute__((ext_vector_type(4)));
typedef float f32x2 __attribute__((ext_vector_type(2)));
typedef unsigned u32x4 __attribute__((ext_vector_type(4)));
typedef unsigned u32x2 __attribute__((ext_vector_type(2)));

constexpr int NTHREADS = 512, NWAVES = 8;
constexpr int RING_BYTES = 131072, LDS_BYTES = RING_BYTES + 4096;
constexpr size_t MiB = 1u << 20;
constexpr size_t WS_MOD = 0, WS_ROPEC = 1 * MiB, WS_ROPES = WS_ROPEC + 512 * 1024, WS_KSUM = 2 * MiB;
constexpr size_t WS_CTL = 3 * MiB;
constexpr size_t WS_WIN = 4 * MiB, WS_WOUT = 24 * MiB, WS_WGU = 32 * MiB, WS_WDN = 76 * MiB;
constexpr size_t WS_U = 98 * MiB, WS_Q = 226 * MiB, WS_K = 290 * MiB, WS_V = 354 * MiB, WS_GLU = 418 * MiB, WS_AC = 482 * MiB;
constexpr size_t WS_ACT = 226 * MiB;
constexpr size_t WS_H1 = 610 * MiB;
constexpr size_t WS_H2 = WS_U;
constexpr size_t WS_END = 738 * MiB;
static_assert(WS_WIN + (size_t)INW * DM * 2 <= WS_WOUT && WS_WOUT + (size_t)DM * DM * 2 <= WS_WGU && WS_WGU + (size_t)2 * DFF * DM * 2 <= WS_WDN && WS_WDN + (size_t)DM * DFF * 2 <= WS_U, "weights map");
static_assert(WS_U + (size_t)MROWS * DM * 2 <= WS_Q && WS_ACT + (size_t)MROWS * DFF * 2 <= WS_END && WS_AC + (size_t)MROWS * DM * 2 <= WS_END, "activation map");

struct Args {
    const float *x, *c, *w_ada, *b_ada, *g_mix, *w_in, *conv_w, *conv_b, *ln_g, *ln_b, *w_out, *g_ffn, *w_gate, *w_up, *w_down, *g_final;
    float* out; unsigned char* ws; int ph_lo, ph_hi;
};

__device__ const double INVREV[64] = {
1.59154943091895346e-01, 1.37822502603982849e-01, 1.19349370211248862e-01, 1.03352296618434064e-01,
8.94994016088910133e-02, 7.75032887553740585e-02, 6.71150830052272551e-02, 5.81192674418762462e-02,
5.03292121044870353e-02, 4.35833021053073297e-02, 3.77415847174197711e-02, 3.26828658723569976e-02,
2.83021958306233987e-02, 2.45086918620698521e-02, 2.12236527647776604e-02, 1.83789261056796667e-02,
1.59154943091895339e-02, 1.37822502603982839e-02, 1.19349370211248862e-02, 1.03352296618434061e-02,
8.94994016088910237e-03, 7.75032887553740550e-03, 6.71150830052272534e-03, 5.81192674418762410e-03,
5.03292121044870370e-03, 4.35833021053073314e-03, 3.77415847174197719e-03, 3.26828658723569932e-03,
2.83021958306233987e-03, 2.45086918620698521e-03, 2.12236527647776622e-03, 1.83789261056796667e-03,
1.59154943091895356e-03, 1.37822502603982878e-03, 1.19349370211248849e-03, 1.03352296618434048e-03,
8.94994016088910237e-04, 7.75032887553740507e-04, 6.71150830052272599e-04, 5.81192674418762388e-04,
5.03292121044870326e-04, 4.35833021053073292e-04, 3.77415847174197741e-04, 3.26828658723569922e-04,
2.83021958306233954e-04, 2.45086918620698543e-04, 2.12236527647776605e-04, 1.83789261056796662e-04,
1.59154943091895351e-04, 1.37822502603982856e-04, 1.19349370211248862e-04, 1.03352296618434061e-04,
8.94994016088910182e-05, 7.75032887553740561e-05, 6.71150830052272545e-05, 5.81192674418762388e-05,
5.03292121044870354e-05, 4.35833021053073225e-05, 3.77415847174197768e-05, 3.26828658723569989e-05,
2.83021958306233961e-05, 2.45086918620698523e-05, 2.12236527647776592e-05, 1.83789261056796682e-05
};

__device__ __forceinline__ unsigned f2bf(float f) { unsigned u = __builtin_bit_cast(unsigned, f); return (u + 0x7fffu + ((u >> 16) & 1u)) >> 16; }
__device__ __forceinline__ unsigned pk2(float lo, float hi) { return f2bf(lo) | (f2bf(hi) << 16); }
__device__ __forceinline__ float wave_sum(float v) {
#pragma unroll
    for (int o = 1; o < 64; o <<= 1) v += __shfl_xor(v, o);
    return v;
}
#define LDS_WAIT() asm volatile("s_waitcnt lgkmcnt(0)" ::: "memory")

__device__ __forceinline__ void transpose_item(const float* __restrict__ W, int N, int col0, int k0, bf16_t* __restrict__ WT, int K, int n0, LAS unsigned* scr, int lane) {
    {
        float v[64];
        const float* wp = W + (size_t)k0 * N + col0 + lane;
#pragma unroll
        for (int i = 0; i < 64; ++i) v[i] = __builtin_nontemporal_load(wp + (size_t)i * N);
#pragma unroll
        for (int i = 0; i < 32; ++i) scr[lane * 36 + i] = pg8::cvt_pk_bf16(v[2 * i], v[2 * i + 1]);
    }
    LDS_WAIT(); asm volatile("" ::: "memory");
#pragma unroll
    for (int j = 0; j < 8; ++j) { const int n = j * 8 + (lane >> 3), ch = lane & 7;
        const u32x4 o = *(const LAS u32x4*)(scr + n * 36 + ch * 4);
        *(u32x4*)(WT + (size_t)(n0 + n) * K + k0 + ch * 8) = o; }
    LDS_WAIT(); asm volatile("" ::: "memory");
}

__device__ __forceinline__ void phase0(const Args& a, LAS unsigned char* lds, int G) {
    const int tid = threadIdx.x, lane = tid & 63, wave = __builtin_amdgcn_readfirstlane(tid >> 6), bx = blockIdx.x;
    float* MOD = (float*)(a.ws + WS_MOD); float* RC = (float*)(a.ws + WS_ROPEC); float* RS = (float*)(a.ws + WS_ROPES); float* KSUM = (float*)(a.ws + WS_KSUM);
    if (bx == 0) { unsigned* ctl = (unsigned*)(a.ws + WS_CTL); for (int i = tid; i < 4096; i += NTHREADS) __hip_atomic_store(ctl + i, 0u, __ATOMIC_RELAXED, __HIP_MEMORY_SCOPE_AGENT); }
    {
        const int gt = bx * NTHREADS + tid, NT = G * NTHREADS;
        for (int i = gt; i < BATCH * NH * 8 * HD; i += NT) KSUM[i] = 0.f;
        for (int i = gt; i < SEQ * 64; i += NT) { const int t = i >> 6, j = i & 63; double rev = (double)t * INVREV[j]; rev -= __builtin_floor(rev); const float fr = (float)rev;
            RC[i] = __builtin_amdgcn_cosf(fr); RS[i] = __builtin_amdgcn_sinf(fr); }
    }
    for (int s = ((G % 8 == 0) ? (bx % 8) * (G / 8) + bx / 8 : bx); s < 256; s += G) {
        const int n0 = s * 48, kbeg = wave * 256, lb = lane & 15, kq = lane >> 4;
        float csr[64];
        { const float* cp = a.c + (size_t)lb * DM + kbeg + kq;
#pragma unroll
          for (int j = 0; j < 64; ++j) { const float cv = cp[4 * j]; csr[j] = cv * __builtin_amdgcn_rcpf(1.0f + __expf(-cv)); } }
        f32x4 acc0 = (f32x4){0.f, 0.f, 0.f, 0.f}, acc1 = acc0, acc2 = acc0;
        const float* wp = a.w_ada + (size_t)(kbeg + kq) * NMODC + n0 + lb;
#pragma unroll
        for (int j = 0; j < 64; ++j) {
            const float w0 = wp[(size_t)(4 * j) * NMODC], w1 = wp[(size_t)(4 * j) * NMODC + 16], w2 = wp[(size_t)(4 * j) * NMODC + 32];
            acc0 = __builtin_amdgcn_mfma_f32_16x16x4f32(csr[j], w0, acc0, 0, 0, 0);
            acc1 = __builtin_amdgcn_mfma_f32_16x16x4f32(csr[j], w1, acc1, 0, 0, 0);
            acc2 = __builtin_amdgcn_mfma_f32_16x16x4f32(csr[j], w2, acc2, 0, 0, 0);
        }
        LAS float* red = (LAS float*)lds;
#pragma unroll
        for (int e = 0; e < 4; ++e) { LAS float* rp = red + (wave * 16 + 4 * kq + e) * 48 + lb; rp[0] = acc0[e]; rp[16] = acc1[e]; rp[32] = acc2[e]; }
        __syncthreads();
        for (int i = tid; i < 16 * 48; i += NTHREADS) { const int b = i / 48, l = i - b * 48; float sum = a.b_ada[n0 + l];
#pragma unroll
            for (int w = 0; w < 8; ++w) sum += red[(w * 16 + b) * 48 + l];
            MOD[(size_t)b * NMODC + n0 + l] = sum; }
        __syncthreads();
    }
}

constexpr int I_IN = 32 * 80, I_OUT = 32 * 32, I_GU = 32 * 176, I_DN = 88 * 32;
__device__ __forceinline__ void weight_copies(const Args& a, LAS unsigned char* lds, int G, const int it_lo, const int it_hi) {
    const int tid = threadIdx.x, lane = tid & 63, wave = __builtin_amdgcn_readfirstlane(tid >> 6), bx = blockIdx.x;
    {
        LAS unsigned* scr = (LAS unsigned*)lds + wave * 2304;
        bf16_t* WIN = (bf16_t*)(a.ws + WS_WIN); bf16_t* WOUT = (bf16_t*)(a.ws + WS_WOUT); bf16_t* WGU = (bf16_t*)(a.ws + WS_WGU); bf16_t* WDN = (bf16_t*)(a.ws + WS_WDN);
        const int gw = bx * NWAVES + wave, NGW = G * NWAVES;
        for (int it = it_lo + gw; it < it_hi; it += NGW) {
            int r = it;
            if (r < I_IN) { const int kb = r / 80, nb = r - kb * 80, n0 = nb * 64; int col0;
                if (n0 < 2048) col0 = (n0 & ~0xC0) | ((n0 & 0x40) << 1) | ((n0 & 0x80) >> 1);
                else if (n0 < 3072) col0 = n0;
                else { const int j = n0 - 3072; col0 = 3072 + ((j >> 7) & 1) * 1024 + (j >> 8) * 128 + (j & 127); }
                transpose_item(a.w_in, INW, col0, kb * 64, WIN, DM, n0, scr, lane); continue; }
            r -= I_IN;
            if (r < I_OUT) { const int kb = r >> 5, nb = r & 31; transpose_item(a.w_out, DM, nb * 64, kb * 64, WOUT, DM, nb * 64, scr, lane); continue; }
            r -= I_OUT;
            if (r < I_GU) { const int kb = r / 176, nb = r - kb * 176, n0 = nb * 64; const int col0 = (n0 >> 8) * 128 + (n0 & 127);
                transpose_item(((n0 >> 7) & 1) ? a.w_up : a.w_gate, DFF, col0, kb * 64, WGU, DM, n0, scr, lane); continue; }
            r -= I_GU;
            { const int kb = r >> 5, nb = r & 31; transpose_item(a.w_down, DM, nb * 64, kb * 64, WDN, DFF, nb * 64, scr, lane); }
        }
    }
}

template <int MODE, bool SRC_BF16>
__device__ __forceinline__ void rows_phase(const void* src, const float* __restrict__ g, const float* __restrict__ sc, const float* __restrict__ sh, bf16_t* __restrict__ dst, float* __restrict__ dstf, int G) {
    const int tid = threadIdx.x, lane = tid & 63, wave = __builtin_amdgcn_readfirstlane(tid >> 6);
    const int vb_ = (G % 8 == 0) ? (int)(blockIdx.x % 8) * (G / 8) + (int)(blockIdx.x / 8) : (int)blockIdx.x;
    const int gw = vb_ * NWAVES + wave, NGW = G * NWAVES;
    for (int it = gw; it < MROWS / 16; it += NGW) {
        const int row0 = it * 16, b = row0 >> 11;
        f32x4 pa[4][2], pb[4][2];
#pragma unroll
        for (int j = 0; j < 4; ++j)
#pragma unroll
            for (int h = 0; h < 2; ++h) { const int col = 8 * lane + 512 * j + 4 * h; pa[j][h] = *(const f32x4*)(g + col);
                if (MODE == 0) { pa[j][h] = pa[j][h] * (*(const f32x4*)(sc + (size_t)b * NMODC + col) + 1.0f); pb[j][h] = *(const f32x4*)(sh + (size_t)b * NMODC + col); } }
#pragma unroll 2
        for (int r = 0; r < 16; ++r) {
            const size_t roff = (size_t)(row0 + r) * DM + 8 * lane;
            f32x4 v[4][2]; float ss = 0.f;
#pragma unroll
            for (int j = 0; j < 4; ++j) {
                if (SRC_BF16) { const u32x4 w = __builtin_nontemporal_load((const u32x4*)((const bf16_t*)src + roff + 512 * j));
                    v[j][0] = (f32x4){__uint_as_float(w.x << 16), __uint_as_float(w.x & 0xffff0000u), __uint_as_float(w.y << 16), __uint_as_float(w.y & 0xffff0000u)};
                    v[j][1] = (f32x4){__uint_as_float(w.z << 16), __uint_as_float(w.z & 0xffff0000u), __uint_as_float(w.w << 16), __uint_as_float(w.w & 0xffff0000u)}; }
                else { v[j][0] = __builtin_nontemporal_load((const f32x4*)((const float*)src + roff + 512 * j)); v[j][1] = __builtin_nontemporal_load((const f32x4*)((const float*)src + roff + 512 * j + 4)); }
#pragma unroll
                for (int h = 0; h < 2; ++h) ss += (v[j][h][0] * v[j][h][0] + v[j][h][1] * v[j][h][1]) + (v[j][h][2] * v[j][h][2] + v[j][h][3] * v[j][h][3]); }
            const float rstd = 1.0f / sqrtf(wave_sum(ss) * (1.0f / DM) + EPS);
            if (MODE == 0) {
#pragma unroll
                for (int j = 0; j < 4; ++j) { const f32x4 o0 = v[j][0] * rstd * pa[j][0] + pb[j][0], o1 = v[j][1] * rstd * pa[j][1] + pb[j][1];
                    *(u32x4*)(dst + roff + 512 * j) = pg8::pack8(o0, o1); } }
            else {
#pragma unroll
                for (int j = 0; j < 4; ++j) { *(f32x4*)(dstf + roff + 512 * j) = v[j][0] * rstd * pa[j][0]; *(f32x4*)(dstf + roff + 512 * j + 4) = v[j][1] * rstd * pa[j][1]; } }
        }
    }
}

#ifndef P3_REP
#define P3_REP 1
#endif
__device__ __forceinline__ void conv_phase(const Args& a, LAS unsigned char* lds, int G) {
    const int tid = threadIdx.x, lane = tid & 63, wave = __builtin_amdgcn_readfirstlane(tid >> 6);
    const bf16_t* GLU = (const bf16_t*)(a.ws + WS_GLU); bf16_t* AC = (bf16_t*)(a.ws + WS_AC);
    LAS float* red = (LAS float*)lds;
    LAS float* stat = red + 128;
    f32x2 w[CK];
#pragma unroll
    for (int j = 0; j < CK; ++j) w[j] = *(const f32x2*)(a.conv_w + j * CW + 2 * tid);
    const f32x2 bias = *(const f32x2*)(a.conv_b + 2 * tid), lg = *(const f32x2*)(a.ln_g + 2 * tid), lb = *(const f32x2*)(a.ln_b + 2 * tid);
    for (int ctr = blockIdx.x; ctr < P3_REP * (MROWS / 32); ctr += G) { const int c0_ = ctr % (MROWS / 32);
        const int ct = (G == 256) ? ((c0_ & 7) * 128 + ((c0_ >> 3) & 31) + 32 * (c0_ >> 8)) : c0_;
        const int row0 = ct * 32, t0 = row0 & (SEQ - 1);
        const unsigned* up = (const unsigned*)GLU + (size_t)row0 * (CW / 2) + tid;
        f32x2 x[38];
#pragma unroll
        for (int j = 0; j < 30; ++j) { unsigned p = 0u; if (t0 != 0) p = up[(j - 30) * (CW / 2)]; x[j] = (f32x2){__uint_as_float(p << 16), __uint_as_float(p & 0xffff0000u)}; }
        unsigned nx[8];
#pragma unroll
        for (int o = 0; o < 8; ++o) nx[o] = up[o * (CW / 2)];
        for (int it = 0; it < 4; ++it) {
#pragma unroll
            for (int o = 0; o < 8; ++o) { const unsigned p = nx[o]; x[30 + o] = (f32x2){__uint_as_float(p << 16), __uint_as_float(p & 0xffff0000u)}; }
            if (it < 3) {
#pragma unroll
                for (int o = 0; o < 8; ++o) nx[o] = up[((it + 1) * 8 + o) * (CW / 2)]; }
            f32x2 y[8];
#pragma unroll
            for (int o = 0; o < 8; ++o) y[o] = bias;
#pragma unroll
            for (int j = 0; j < CK; ++j)
#pragma unroll
                for (int o = 0; o < 8; ++o) y[o] += w[j] * x[o + j];
            float sv[16];
#pragma unroll
            for (int o = 0; o < 8; ++o) { sv[2 * o] = y[o][0] + y[o][1]; sv[2 * o + 1] = y[o][0] * y[o][0] + y[o][1] * y[o][1]; }
#pragma unroll
            for (int i = 0; i < 16; ++i) sv[i] = wave_sum(sv[i]);
            if (lane == 0) {
#pragma unroll
                for (int i = 0; i < 16; ++i) red[wave * 16 + i] = sv[i]; }
            __syncthreads();
            if (tid < 8) { float s = 0.f, q = 0.f;
#pragma unroll
                for (int wv = 0; wv < 8; ++wv) { s += red[wv * 16 + 2 * tid]; q += red[wv * 16 + 2 * tid + 1]; }
                const float mean = s * (1.0f / CW), var = q * (1.0f / CW) - mean * mean;
                stat[2 * tid] = mean; stat[2 * tid + 1] = 1.0f / sqrtf(fmaxf(var, 0.f) + EPS); }
            __syncthreads();
#pragma unroll
            for (int o = 0; o < 8; ++o) { const float mean = stat[2 * o], rstd = stat[2 * o + 1];
                const f32x2 yn = (y[o] - mean) * rstd * lg + lb;
                const float o0 = yn[0] * pg8::sigmoid_fast(yn[0]), o1 = yn[1] * pg8::sigmoid_fast(yn[1]);
                *((unsigned*)(AC + (size_t)(row0 + it * 8 + o) * DM + CW) + tid) = pk2(o0, o1); }
#pragma unroll
            for (int j = 0; j < 30; ++j) x[j] = x[j + 8];
        }
    }
}

__device__ __forceinline__ att::BlockRef attn_ref(int vcu, int G, int s) {
    const int Lv = vcu + (s >> 1) * G, y = Lv & 3;
    att::BlockRef r; r.bh = Lv >> 2; r.blk = (s & 1) ? 7 - y : y;
    return r;
}
__device__ __forceinline__ void attn_phase(const Args& a, char* lds, int vcu, int G) {
    static_assert(WS_V - WS_K == 64 * MiB, "att::VOFF");
    int nitems = 0; for (int i = 0; vcu + i * G < BATCH * NH * 4; ++i) ++nitems;
    const int ns = 2 * nitems; if (ns == 0) return;
    att::Tensors T; T.Q = (const bf16_t*)(a.ws + WS_Q); T.K = (const bf16_t*)(a.ws + WS_K); T.O = (bf16_t*)(a.ws + WS_AC); T.KS = (const float*)(a.ws + WS_KSUM);
    att::Seam S; att::BlockRef cur = attn_ref(vcu, G, 0);
    att::moba_prime(T, cur, lds, S);
#ifndef P3_REP
#define P3_REP 1
#endif
    for (int s = 0; s < ns * P3_REP; ++s) {
        const att::BlockRef nxt = (s + 1 < ns * P3_REP) ? attn_ref(vcu, G, (s + 1) % ns) : cur;
        att::moba_block(T, cur, nxt, lds, S);
        cur = nxt;
    }
}

#define RLX_AGENT __ATOMIC_RELAXED, __HIP_MEMORY_SCOPE_AGENT
#define XB_TMO      128
#define XB_XCNT(j)  (256  + 64 * (j))
#define XB_XSUB(j)  (1280 + 64 * (j))
#define XB_XGEN(j)  (2304 + 64 * (j))
#define XB_TOP      3328
#define XB_TOPGEN   3392
#define XCD_BAR_WORDS 3456
#define XB_SPIN_CAP (1u << 18)

__device__ __forceinline__ unsigned xb_ld(unsigned* p)              { return __hip_atomic_load(p, __ATOMIC_RELAXED, __HIP_MEMORY_SCOPE_AGENT); }
__device__ __forceinline__ unsigned xb_add(unsigned* p, unsigned v) { return __hip_atomic_fetch_add(p, v, __ATOMIC_RELAXED, __HIP_MEMORY_SCOPE_AGENT); }
__device__ __forceinline__ unsigned xb_xcc_id() { return (unsigned)__builtin_amdgcn_s_getreg((3 << 11) | 20) & 0xFu; }
#define XB_SPIN(cond, bar) do { unsigned _sp = 0; while (cond) { __builtin_amdgcn_s_sleep(1); \
    if ((++_sp & 255u) == 0u) { if (xb_ld(&(bar)[XB_TMO])) break; if (_sp > XB_SPIN_CAP) { atomicAdd(&(bar)[XB_TMO], 1u); break; } } } } while (0)

struct XcdBarrier {
    unsigned* bar; unsigned x;
    volatile LAS unsigned* st;
};

__device__ __forceinline__ XcdBarrier xcd_barrier_post(unsigned* bar, volatile LAS unsigned* st) {
    XcdBarrier b; b.bar = bar; b.x = xb_xcc_id(); b.st = st;
    if (threadIdx.x == 0) (void)xb_add(&bar[XB_XCNT(b.x)], 1u);
    return b;
}
__device__ __forceinline__ void xcd_barrier_complete(unsigned* bar, unsigned x, unsigned& nloc, unsigned& nx) {
    const unsigned G = gridDim.x * gridDim.y * gridDim.z;
    unsigned sum, cnt, mine, sp = 0u;
    for (;;) {
        sum = 0u; cnt = 0u; mine = 0u;
#pragma unroll
        for (unsigned j = 0; j < 16; ++j) { const unsigned c = xb_ld(&bar[XB_XCNT(j)]); sum += c; cnt += (c > 0u) ? 1u : 0u; mine = (j == x) ? c : mine; }
        if (sum == G) break;
        __builtin_amdgcn_s_sleep(1);
        if ((++sp & 255u) == 0u) { if (xb_ld(&bar[XB_TMO])) break; if (sp > XB_SPIN_CAP) { atomicAdd(&bar[XB_TMO], 1u); break; } }
    }
    nloc = mine > 0u ? mine : 1u; nx = cnt > 0u ? cnt : 1u;
}

__device__ __forceinline__ void xcd_barrier(const XcdBarrier& b) {
    asm volatile("s_waitcnt vmcnt(0)" ::: "memory");
    __syncthreads();
    if (threadIdx.x == 0) {
        unsigned* bar = b.bar;
        __builtin_amdgcn_s_waitcnt(0);
        unsigned nloc = b.st[0], nx = b.st[1];
        if (nloc == 0u) { xcd_barrier_complete(bar, b.x, nloc, nx); b.st[0] = nloc; b.st[1] = nx; }
        const unsigned old = xb_add(&bar[XB_XSUB(b.x)], 1u);
        const unsigned gen = old / nloc;
        if (old + 1u == (gen + 1u) * nloc) {
            __builtin_amdgcn_fence(__ATOMIC_RELEASE, "agent");
            asm volatile("s_waitcnt vmcnt(0)" ::: "memory");
            const unsigned og = xb_add(&bar[XB_TOP], 1u);
            const unsigned tg = og / nx;
            if (og + 1u == (tg + 1u) * nx) xb_add(&bar[XB_TOPGEN], 1u);
            else XB_SPIN(xb_ld(&bar[XB_TOPGEN]) == tg, bar);
            __builtin_amdgcn_fence(__ATOMIC_ACQUIRE, "agent");
            xb_add(&bar[XB_XGEN(b.x)], 1u);
            asm volatile("s_waitcnt vmcnt(0)" ::: "memory");
        } else {
            XB_SPIN(xb_ld(&bar[XB_XGEN(b.x)]) == gen, bar);
            __builtin_amdgcn_fence(__ATOMIC_ACQUIRE, "agent");
            asm volatile("s_waitcnt vmcnt(0)" ::: "memory");
        }
    }
    __syncthreads();
}

typedef const __attribute__((address_space(4))) Args* ArgsP;
__device__ __forceinline__ Args load_args() {
#if defined(__HIP_DEVICE_COMPILE__)
    ArgsP p = (ArgsP)__builtin_amdgcn_kernarg_segment_ptr(); asm volatile("" : "+s"(p)); return *p;
#else
    return Args{};
#endif
}
__global__ void __launch_bounds__(NTHREADS, 2) mega_fwd(Args a_unused) {
    extern __shared__ __attribute__((aligned(16))) unsigned char lds_raw[];
    LAS unsigned char* lds = (LAS unsigned char*)lds_raw;
    const int G = gridDim.x, bx = blockIdx.x;
    const int vcu = (G % 8 == 0) ? (bx % 8) * (G / 8) + bx / 8 : bx;
    cg::grid_group grid = cg::this_grid();
    volatile LAS unsigned* bst = (volatile LAS unsigned*)(lds + RING_BYTES);
    if (threadIdx.x < 4) bst[threadIdx.x] = 0u;
    __syncthreads();
    XcdBarrier bar; bar.bar = nullptr; bar.x = 0; bar.st = bst;
    const int lo = a_unused.ph_lo, hi = a_unused.ph_hi;
#ifndef PH_MASK
#define PH_MASK 0x1ff
#endif
#ifndef REP_MASK
#define REP_MASK 0
#endif
#define IN(k) (((PH_MASK >> (k)) & 1) && lo <= (k) && (k) < hi)
#define REP(k) for (int rep_ = 0; rep_ < 1 + ((REP_MASK >> (k)) & 1); ++rep_)
#define SEAM(k) do { if (IN(k) && IN((k) + 1)) { if ((k) == 0) { grid.sync(); bar = xcd_barrier_post((unsigned*)(load_args().ws + WS_CTL), bst); } else xcd_barrier(bar); } } while (0)
    if (IN(0)) REP(0) { const Args a = load_args(); phase0(a, lds, G); } SEAM(0);
    if (IN(1)) REP(1) { const Args a = load_args(); float* MOD = (float*)(a.ws + WS_MOD); rows_phase<0, false>(a.x, a.g_mix, MOD + DM, MOD, (bf16_t*)(a.ws + WS_U), nullptr, G); weight_copies(a, lds, G, 0, I_IN + I_OUT); } SEAM(1);
    if (IN(2)) REP(2) { const Args a = load_args();
        pg8::Gemm g{(const bf16_t*)(a.ws + WS_U), (const bf16_t*)(a.ws + WS_WIN), MROWS, INW, DM}; pg8::StaticOrder S; S.init(MROWS, INW, G, bx, 4);
        pg8::EpiIn E{(bf16_t*)(a.ws + WS_Q), (bf16_t*)(a.ws + WS_K), (bf16_t*)(a.ws + WS_V), (bf16_t*)(a.ws + WS_GLU), (float*)(a.ws + WS_KSUM), (const float*)(a.ws + WS_ROPEC), (const float*)(a.ws + WS_ROPES)};
        pg8::gemm_phase<pg8::EpiIn, pg8::StaticOrder, true, true>(lds, g, S, E);
    } SEAM(2);
    if (IN(3)) REP(3) {
#ifndef NO_ATTN
        { const Args a = load_args(); attn_phase(a, (char*)lds_raw, vcu, G); } __syncthreads();
#endif
#ifndef NO_CONV
        { const Args a = load_args(); conv_phase(a, lds, G); } __syncthreads();
#endif
    } SEAM(3);
    if (IN(4)) REP(4) { const Args a = load_args();
        pg8::Gemm g{(const bf16_t*)(a.ws + WS_AC), (const bf16_t*)(a.ws + WS_WOUT), MROWS, DM, DM}; pg8::StaticOrder S; S.init(MROWS, DM, G, bx, 4);
        pg8::EpiRes<false> E{a.x, (bf16_t*)(a.ws + WS_H1), (const float*)(a.ws + WS_MOD) + 2 * DM};
        pg8::gemm_phase<pg8::EpiRes<false>, pg8::StaticOrder, true, true>(lds, g, S, E);
    } SEAM(4);
    if (IN(5)) REP(5) { const Args a = load_args(); float* MOD = (float*)(a.ws + WS_MOD); weight_copies(a, lds, G, I_IN + I_OUT, I_IN + I_OUT + I_GU + I_DN); rows_phase<0, true>(a.ws + WS_H1, a.g_ffn, MOD + 4 * DM, MOD + 3 * DM, (bf16_t*)(a.ws + WS_U), nullptr, G); } SEAM(5);
    if (IN(6)) REP(6) { const Args a = load_args();
        pg8::Gemm g{(const bf16_t*)(a.ws + WS_U), (const bf16_t*)(a.ws + WS_WGU), MROWS, 2 * DFF, DM}; pg8::StaticOrder S; S.init(MROWS, 2 * DFF, G, bx, 4);
        pg8::EpiGU E{(bf16_t*)(a.ws + WS_ACT)};
        pg8::gemm_phase<pg8::EpiGU, pg8::StaticOrder, true, true>(lds, g, S, E);
    } SEAM(6);
    if (IN(7)) REP(7) { const Args a = load_args();
        pg8::Gemm g{(const bf16_t*)(a.ws + WS_ACT), (const bf16_t*)(a.ws + WS_WDN), MROWS, DM, DFF}; pg8::StaticOrder S; S.init(MROWS, DM, G, bx, 4); S.rev = 1;
        pg8::EpiRes<true> E{a.ws + WS_H1, (bf16_t*)(a.ws + WS_H2), (const float*)(a.ws + WS_MOD) + 5 * DM};
        pg8::gemm_phase<pg8::EpiRes<true>, pg8::StaticOrder, true, true>(lds, g, S, E);
    } SEAM(7);
    if (IN(8)) REP(8) { const Args a = load_args(); rows_phase<1, true>(a.ws + WS_H2, a.g_final, nullptr, nullptr, nullptr, a.out, G); }
#undef IN
#undef SEAM
}

#ifndef MK_N_LAUNCHES
#define MK_N_LAUNCHES 1
#endif
extern "C" void kernel_launch(void* const* d_in, const int* in_sizes, int n_in, void* d_out, int out_size, void* d_ws, size_t ws_size, hipStream_t stream) {
    static int grid = 0;
    if (grid == 0) {
        if (n_in != 16 || in_sizes[0] != MROWS * DM || out_size != MROWS * DM || ws_size < WS_END) {
            fprintf(stderr, "kernel_launch: unexpected shapes (n_in %d, in0 %d, out %d, ws %zu); nothing launched\n", n_in, n_in > 0 ? in_sizes[0] : -1, out_size, ws_size); grid = -1; return; }
        int dev = 0, cus = 0, per_cu = 0;
        (void)hipGetDevice(&dev); (void)hipDeviceGetAttribute(&cus, hipDeviceAttributeMultiprocessorCount, dev);
        if (hipFuncSetAttribute((const void*)mega_fwd, hipFuncAttributeMaxDynamicSharedMemorySize, LDS_BYTES) != hipSuccess) { fprintf(stderr, "kernel_launch: hipFuncSetAttribute failed\n"); grid = -1; return; }
        if (hipOccupancyMaxActiveBlocksPerMultiprocessor(&per_cu, (const void*)mega_fwd, NTHREADS, LDS_BYTES) != hipSuccess || per_cu < 1) { fprintf(stderr, "kernel_launch: occupancy query gave %d\n", per_cu); per_cu = 1; }
        (void)hipGetLastError();
        if (cus <= 0) cus = 256;
        grid = cus * per_cu;
        fprintf(stderr, "kernel_launch: grid %d (cus %d x %d)\n", grid, cus, per_cu);
    }
    if (grid < 0) return;
    Args a{};
    a.x = (const float*)d_in[0]; a.c = (const float*)d_in[1]; a.w_ada = (const float*)d_in[2]; a.b_ada = (const float*)d_in[3]; a.g_mix = (const float*)d_in[4];
    a.w_in = (const float*)d_in[5]; a.conv_w = (const float*)d_in[6]; a.conv_b = (const float*)d_in[7]; a.ln_g = (const float*)d_in[8]; a.ln_b = (const float*)d_in[9];
    a.w_out = (const float*)d_in[10]; a.g_ffn = (const float*)d_in[11]; a.w_gate = (const float*)d_in[12]; a.w_up = (const float*)d_in[13]; a.w_down = (const float*)d_in[14]; a.g_final = (const float*)d_in[15];
    a.out = (float*)d_out; a.ws = (unsigned char*)d_ws;
    constexpr int NPH = 9;
    if (MK_N_LAUNCHES == 1) {
        a.ph_lo = 0; a.ph_hi = NPH;
        void* args[] = {&a};
        const hipError_t e = hipLaunchCooperativeKernel((const void*)mega_fwd, dim3(grid), dim3(NTHREADS), args, LDS_BYTES, stream);
        if (e != hipSuccess) fprintf(stderr, "kernel_launch: cooperative launch failed: %s (grid %d)\n", hipGetErrorString(e), grid);
    } else {
        for (int p = 0; p < NPH; ++p) { a.ph_lo = p; a.ph_hi = p + 1; hipLaunchKernelGGL(mega_fwd, dim3(grid), dim3(NTHREADS), LDS_BYTES, stream, a); }
    }
}
```

```cpp
#include <hip/hip_runtime.h>
#include <hip/hip_cooperative_groups.h>
#include <cstdio>
#include <cstdint>
namespace cg = cooperative_groups;

constexpr int DM = 2048, BATCH = 16, SEQ = 2048, MROWS = BATCH * SEQ;
constexpr int NH = 8, HD = 128, AW = 1024, CW = 1024, INW = 5120, CK = 31, DFF = 5632, NMODC = 6 * DM;
constexpr float EPS = 1e-6f;

namespace pg8 {
#define PG8_LAS __attribute__((address_space(3)))
typedef unsigned short bf16_t;
typedef short bf16x8 __attribute__((ext_vector_type(8)));
typedef float f32x4 __attribute__((ext_vector_type(4)));
typedef unsigned u32x4 __attribute__((ext_vector_type(4)));
constexpr int BM = 256, BK = 64, HALF = 128, HTB = HALF * BK * 2  , STAGE_BYTES = 8 * HTB, NXCD = 8, WGM = 8;

__host__ __device__ __forceinline__ int lds_byte(int r, int c) { const int st = (r >> 4) * 2 + (c >> 5), rr = r & 15, cc = c & 31, ob = rr * 64 + cc * 2; return st * 1024 + (ob ^ (((ob >> 9) & 1) << 5)); }
__host__ __device__ __forceinline__ void stage_rc(int b, int& R, int& C) { const int st = b / 1024, sb = b % 1024, swz = sb ^ (((sb >> 9) & 1) << 5); R = (st >> 1) * 16 + swz / 64; C = (st & 1) * 32 + (swz % 64) / 2; }
__host__ __device__ __forceinline__ int perm32(int rho) { const int n = rho >> 4, i = rho & 15; return 8 * (i >> 2) + 4 * n + (i & 3); }

struct Unit { int pm, pn; };
struct Gemm { const bf16_t* A; const bf16_t* Bt; int M, N, K; };

struct StaticOrder {
    int nM, nN, nwg, G, c, wgm, rev = 0;
    __host__ __device__ void init(int M, int N, int G_, int c_, int wgm_ = WGM) { nM = M / BM; nN = N / BM; nwg = nM * nN; G = G_; c = c_; wgm = wgm_; }
    __host__ __device__ bool next(int i, Unit& u) const {
        const long L = (long)i * G + c; if (L >= nwg) return false;
        int wgid = (int)L; { const int q = nwg / NXCD, r = nwg % NXCD, xcd = wgid % NXCD, off = wgid / NXCD; wgid = (xcd < r ? xcd * (q + 1) : r * (q + 1) + (xcd - r) * q) + off; }
        const int nig = wgm * nN, gid = wgid / nig, fm = gid * wgm, gsz = (nM - fm) < wgm ? (nM - fm) : wgm;
        u.pm = fm + ((wgid % nig) % gsz); u.pn = (wgid % nig) / gsz; if (rev) u.pm = (u.pm & ~15) | (15 - (u.pm & 15)); return true;
    }
    __device__ __forceinline__ void a_ready(const Unit&) const {}
    __device__ __forceinline__ void done(const Unit&) const {}
};


__device__ __forceinline__ unsigned cvt_pk_bf16(float lo, float hi) { unsigned r; asm volatile("v_cvt_pk_bf16_f32 %0, %1, %2" : "=v"(r) : "v"(lo), "v"(hi)); return r; }
__device__ __forceinline__ float sigmoid_fast(float x) { return __builtin_amdgcn_rcpf(1.0f + __builtin_amdgcn_exp2f(-1.4426950408889634f * x)); }
__device__ __forceinline__ u32x4 pack8(const f32x4 a, const f32x4 b) { u32x4 w; w.x = cvt_pk_bf16(a[0], a[1]); w.y = cvt_pk_bf16(a[2], a[3]); w.z = cvt_pk_bf16(b[0], b[1]); w.w = cvt_pk_bf16(b[2], b[3]); return w; }

struct EpiIn {
    static constexpr bool PERM = true, AFTER_DRAIN = false;
    bf16_t* Q; bf16_t* K; bf16_t* V; bf16_t* GLU; float* KSUM; const float* RC; const float* RS;
    __device__ __forceinline__ void operator()(const f32x4 (&acc)[2][2][4][2], const Unit& u, int wr, int wc, int fr, int fq) const {
        const int b = u.pm >> 3, blk = u.pm & 7, pn = u.pn;
        const int t0 = blk * 256 + wr * 64 + fr;
        if (pn < 8) {
            const int hh = (pn & 3) * 2 + (wc >> 1), dl = (wc & 1) * 32 + fq * 8;
            const bool isk = pn >= 4;
            bf16_t* dst = (isk ? K : Q) + (size_t)(b * NH + hh) * SEQ * HD + dl;
            f32x4 ks[2][2];
#pragma unroll
            for (int i = 0; i < 2; ++i)
#pragma unroll
                for (int j = 0; j < 2; ++j) ks[i][j] = (f32x4){0.f, 0.f, 0.f, 0.f};
#pragma unroll
            for (int ai = 0; ai < 2; ++ai)
#pragma unroll
                for (int m = 0; m < 4; ++m) {
                    const int t = t0 + ai * 128 + m * 16;
                    const f32x4 c0 = *(const f32x4*)(RC + t * 64 + dl), c1 = *(const f32x4*)(RC + t * 64 + dl + 4);
                    const f32x4 s0 = *(const f32x4*)(RS + t * 64 + dl), s1 = *(const f32x4*)(RS + t * 64 + dl + 4);
                    const f32x4 a0 = acc[ai][0][m][0], a1 = acc[ai][0][m][1], b0 = acc[ai][1][m][0], b1 = acc[ai][1][m][1];
                    const f32x4 o10 = a0 * c0 - b0 * s0, o11 = a1 * c1 - b1 * s1, o20 = b0 * c0 + a0 * s0, o21 = b1 * c1 + a1 * s1;
                    *(u32x4*)(dst + (size_t)t * HD) = pack8(o10, o11);
                    *(u32x4*)(dst + (size_t)t * HD + 64) = pack8(o20, o21);
                    ks[0][0] += o10; ks[0][1] += o11; ks[1][0] += o20; ks[1][1] += o21;
                    asm volatile("" ::: "memory");
                }
            if (isk) {
#pragma unroll
                for (int i = 0; i < 2; ++i)
#pragma unroll
                    for (int j = 0; j < 2; ++j)
#pragma unroll
                        for (int e = 0; e < 4; ++e) { float v = ks[i][j][e]; v += __shfl_xor(v, 1); v += __shfl_xor(v, 2); v += __shfl_xor(v, 4); v += __shfl_xor(v, 8); ks[i][j][e] = v; }
                if (fr == 0) { float* kp = KSUM + ((size_t)(b * NH + hh) * 8 + blk) * HD + dl;
#pragma unroll
                    for (int i = 0; i < 2; ++i)
#pragma unroll
                        for (int j = 0; j < 2; ++j)
#pragma unroll
                            for (int e = 0; e < 4; ++e) atomicAdd(kp + i * 64 + j * 4 + e, ks[i][j][e]); }
            }
        } else if (pn < 12) {
#pragma unroll
            for (int bj = 0; bj < 2; ++bj) {
                bf16_t* dst = V + (size_t)(b * NH + (pn - 8) * 2 + bj) * SEQ * HD + wc * 32 + fq * 8;
#pragma unroll
                for (int ai = 0; ai < 2; ++ai)
#pragma unroll
                    for (int m = 0; m < 4; ++m) { const int t = t0 + ai * 128 + m * 16; *(u32x4*)(dst + (size_t)t * HD) = pack8(acc[ai][bj][m][0], acc[ai][bj][m][1]); }
            }
        } else {
            bf16_t* dst = GLU + (size_t)(u.pm * BM + wr * 64 + fr) * CW + (pn - 12) * 128 + wc * 32 + fq * 8;
#pragma unroll
            for (int ai = 0; ai < 2; ++ai)
#pragma unroll
                for (int m = 0; m < 4; ++m) {
                    f32x4 v0 = acc[ai][0][m][0], v1 = acc[ai][0][m][1]; const f32x4 g0 = acc[ai][1][m][0], g1 = acc[ai][1][m][1];
#pragma unroll
                    for (int e = 0; e < 4; ++e) { v0[e] *= sigmoid_fast(g0[e]); v1[e] *= sigmoid_fast(g1[e]); }
                    *(u32x4*)(dst + (size_t)(ai * 128 + m * 16) * CW) = pack8(v0, v1);
                }
        }
    }
};
template <bool BASE_BF16>
struct EpiRes {
    static constexpr bool PERM = true, AFTER_DRAIN = false;
    const void* base; bf16_t* outb; const float* gate;
    __device__ __forceinline__ void operator()(const f32x4 (&acc)[2][2][4][2], const Unit& u, int wr, int wc, int fr, int fq) const {
        const int b = u.pm >> 3, col0 = u.pn * BM + wc * 32 + fq * 8;
        f32x4 gv[2][2];
#pragma unroll
        for (int bj = 0; bj < 2; ++bj)
#pragma unroll
            for (int n = 0; n < 2; ++n) gv[bj][n] = *(const f32x4*)(gate + (size_t)b * NMODC + col0 + bj * HALF + n * 4);
#pragma unroll
        for (int ai = 0; ai < 2; ++ai)
#pragma unroll
            for (int m = 0; m < 4; ++m) { const size_t off = (size_t)(u.pm * BM + ai * HALF + wr * 64 + m * 16 + fr) * DM + col0;
                f32x4 x[2][2];
#pragma unroll
                for (int bj = 0; bj < 2; ++bj) {
                    if (BASE_BF16) { const u32x4 w = *(const u32x4*)((const bf16_t*)base + off + bj * HALF);
                        x[bj][0] = (f32x4){__uint_as_float(w.x << 16), __uint_as_float(w.x & 0xffff0000u), __uint_as_float(w.y << 16), __uint_as_float(w.y & 0xffff0000u)};
                        x[bj][1] = (f32x4){__uint_as_float(w.z << 16), __uint_as_float(w.z & 0xffff0000u), __uint_as_float(w.w << 16), __uint_as_float(w.w & 0xffff0000u)}; }
                    else { x[bj][0] = *(const f32x4*)((const float*)base + off + bj * HALF); x[bj][1] = *(const f32x4*)((const float*)base + off + bj * HALF + 4); } }
#pragma unroll
                for (int bj = 0; bj < 2; ++bj) *(u32x4*)(outb + off + bj * HALF) = pack8(x[bj][0] + gv[bj][0] * acc[ai][bj][m][0], x[bj][1] + gv[bj][1] * acc[ai][bj][m][1]);
                asm volatile("" ::: "memory"); }
    }
};
struct EpiGU {
    static constexpr bool PERM = true, AFTER_DRAIN = false;
    bf16_t* ACT;
    __device__ __forceinline__ void operator()(const f32x4 (&acc)[2][2][4][2], const Unit& u, int wr, int wc, int fr, int fq) const {
        bf16_t* dst = ACT + (size_t)(u.pm * BM + wr * 64 + fr) * DFF + u.pn * 128 + wc * 32 + fq * 8;
#pragma unroll
        for (int ai = 0; ai < 2; ++ai)
#pragma unroll
            for (int m = 0; m < 4; ++m) {
                const f32x4 g0 = acc[ai][0][m][0], g1 = acc[ai][0][m][1];
                f32x4 t0 = g0 * -1.4426950408889634f, t1 = g1 * -1.4426950408889634f;
#pragma unroll
                for (int e = 0; e < 4; ++e) { t0[e] = __builtin_amdgcn_exp2f(t0[e]); t1[e] = __builtin_amdgcn_exp2f(t1[e]); }
                t0 = t0 + 1.0f; t1 = t1 + 1.0f;
#pragma unroll
                for (int e = 0; e < 4; ++e) { t0[e] = __builtin_amdgcn_rcpf(t0[e]); t1[e] = __builtin_amdgcn_rcpf(t1[e]); }
                const f32x4 v0 = (acc[ai][1][m][0] * g0) * t0, v1 = (acc[ai][1][m][1] * g1) * t1;
                __builtin_nontemporal_store(pack8(v0, v1), (u32x4*)(dst + (size_t)(ai * 128 + m * 16) * DFF));
            }
    }
};

template <class Epi, class Sched, bool ALIGN_EPI = false, bool SP2 = false>
__device__ __forceinline__ void gemm_phase(PG8_LAS unsigned char* lds, const Gemm g, const Sched& S, const Epi& E) {
    const int tid = threadIdx.x, wid = __builtin_amdgcn_readfirstlane(tid >> 6), lane = tid & 63, wr = wid >> 2, wc = wid & 3, fr = lane & 15, fq = lane >> 4;
    const int K = g.K, nt = K / BK;
    unsigned voffA[2], voffB[2];
#pragma unroll
    for (int i = 0; i < 2; ++i) { int R, C; stage_rc(tid * 16 + i * 8192, R, C); const int Rb = Epi::PERM ? ((R & ~31) + perm32(R & 31)) : R;
        voffA[i] = (unsigned)(R * K + C) * 2u; voffB[i] = (unsigned)(Rb * K + C) * 2u; }
    const size_t kstep = (size_t)(BK * 2);
    const size_t hstep = (size_t)HALF * K * 2;
    const size_t tstep = 2 * hstep;
    const unsigned ldsw = (unsigned)wid * 1024u;
    const int aoff = lds_byte(wr * 64 + fr, fq * 8), boff = lds_byte(wc * 32 + fr, fq * 8);
#define PG8_SA(b, h) (((b) * 2 + (h)) * HTB)
#define PG8_SB(b, h) ((4 + (b) * 2 + (h)) * HTB)
#define PG8_STAGE(bufoff, gbase, voff) do { _Pragma("unroll") for (int _i = 0; _i < 2; ++_i) \
        __builtin_amdgcn_global_load_lds((const unsigned*)((const char*)(gbase) + (voff)[_i]), (PG8_LAS unsigned*)(lds + (bufoff) + ldsw + _i * 8192), 16, 0, 0); } while (0)
#define PG8_LDA(dst, b, h) do { _Pragma("unroll") for (int m = 0; m < 4; ++m) _Pragma("unroll") for (int k = 0; k < 2; ++k) dst[m][k] = *(const PG8_LAS bf16x8*)(lds + PG8_SA(b, h) + aoff + m * 2048 + k * 1024); } while (0)
#define PG8_LDB(dst, b, h) do { _Pragma("unroll") for (int n = 0; n < 2; ++n) _Pragma("unroll") for (int k = 0; k < 2; ++k) dst[n][k] = *(const PG8_LAS bf16x8*)(lds + PG8_SB(b, h) + boff + n * 2048 + k * 1024); } while (0)
#define PG8_MMA(ai, bj, At, Bt) do { __builtin_amdgcn_s_setprio(1); _Pragma("unroll") for (int m = 0; m < 4; ++m) _Pragma("unroll") for (int n = 0; n < 2; ++n) _Pragma("unroll") for (int k = 0; k < 2; ++k) \
        acc[ai][bj][m][n] = __builtin_amdgcn_mfma_f32_16x16x32_bf16(Bt[n][k], At[m][k], acc[ai][bj][m][n], 0, 0, 0); __builtin_amdgcn_s_setprio(0); } while (0)
#define PG8_WAIT_V(n) asm volatile("s_waitcnt vmcnt(" #n ")" ::: "memory")
#define PG8_WAIT_L(n) asm volatile("s_waitcnt lgkmcnt(" #n ")" ::: "memory")
#define PG8_BAR __builtin_amdgcn_s_barrier()
#define PG8_SCHED __builtin_amdgcn_sched_barrier(0)
    Unit cur, nxt; int ui = 0;
    if (!S.next(0, cur)) return;
    f32x4 acc[2][2][4][2];
#pragma unroll
    for (int a = 0; a < 2; ++a)
#pragma unroll
        for (int b = 0; b < 2; ++b)
#pragma unroll
            for (int m = 0; m < 4; ++m)
#pragma unroll
                for (int n = 0; n < 2; ++n) acc[a][b][m][n] = (f32x4){0.f, 0.f, 0.f, 0.f};
    bf16x8 At[4][2], B0[2][2], B1[2][2];
    const char* cA = (const char*)g.A + (size_t)cur.pm * tstep; const char* cB = (const char*)g.Bt + (size_t)cur.pn * tstep;
    S.a_ready(cur);
    if constexpr (SP2) {
        PG8_STAGE(PG8_SB(0, 0), cB, voffB); PG8_STAGE(PG8_SB(0, 1), cB + hstep, voffB); PG8_STAGE(PG8_SA(0, 0), cA, voffA); PG8_STAGE(PG8_SA(0, 1), cA + hstep, voffA);
        if (wr == 1) PG8_BAR;
        PG8_WAIT_V(2); PG8_BAR;
        PG8_STAGE(PG8_SB(1, 0), cB + kstep, voffB); PG8_STAGE(PG8_SA(1, 0), cA + kstep, voffA); PG8_STAGE(PG8_SB(1, 1), cB + hstep + kstep, voffB);
        PG8_WAIT_V(6); PG8_BAR;
    } else {
        PG8_STAGE(PG8_SB(0, 0), cB, voffB); PG8_STAGE(PG8_SA(0, 0), cA, voffA); PG8_STAGE(PG8_SB(0, 1), cB + hstep, voffB); PG8_STAGE(PG8_SA(0, 1), cA + hstep, voffA);
        if (wr == 1) PG8_BAR;
        PG8_WAIT_V(4); PG8_BAR;
        PG8_STAGE(PG8_SB(1, 0), cB + kstep, voffB); PG8_STAGE(PG8_SA(1, 0), cA + kstep, voffA); PG8_STAGE(PG8_SB(1, 1), cB + hstep + kstep, voffB);
        PG8_WAIT_V(6); PG8_BAR;
    }
    for (;;) {
        const bool has_next = S.next(ui + 1, nxt);
        const char* nA = has_next ? (const char*)g.A + (size_t)nxt.pm * tstep : cA; const char* nB = has_next ? (const char*)g.Bt + (size_t)nxt.pn * tstep : cB;
        for (int t = 0; t < nt; t += 2) {
            const bool last = (t == nt - 2);
            const char* a1 = cA + (size_t)(t + 1) * kstep;
            const char* a2 = last ? nA : cA + (size_t)(t + 2) * kstep; const char* b2 = last ? nB : cB + (size_t)(t + 2) * kstep;
            const char* a3 = a2 + kstep; const char* b3 = b2 + kstep;
            if (last && has_next) S.a_ready(nxt);
            if constexpr (SP2) {
            PG8_LDB(B0, 0, 0); PG8_LDB(B1, 0, 1); PG8_SCHED; PG8_LDA(At, 0, 0); PG8_STAGE(PG8_SA(1, 1), a1 + hstep, voffA);
            PG8_WAIT_V(8); PG8_WAIT_L(0); PG8_BAR; PG8_MMA(0, 0, At, B0); PG8_MMA(0, 1, At, B1); PG8_BAR; PG8_SCHED;
            PG8_LDA(At, 0, 1); PG8_STAGE(PG8_SB(0, 0), b2, voffB); PG8_STAGE(PG8_SB(0, 1), b2 + hstep, voffB); PG8_STAGE(PG8_SA(0, 0), a2, voffA);
            PG8_WAIT_V(8); PG8_WAIT_L(0); PG8_BAR; PG8_MMA(1, 0, At, B0); PG8_MMA(1, 1, At, B1); PG8_BAR; PG8_SCHED;
            PG8_LDB(B0, 1, 0); PG8_LDB(B1, 1, 1); PG8_SCHED; PG8_LDA(At, 1, 0); PG8_STAGE(PG8_SA(0, 1), a2 + hstep, voffA);
            PG8_WAIT_V(8); PG8_WAIT_L(0); PG8_BAR; PG8_MMA(0, 0, At, B0); PG8_MMA(0, 1, At, B1); PG8_BAR; PG8_SCHED;
            PG8_LDA(At, 1, 1); PG8_STAGE(PG8_SB(1, 0), b3, voffB); PG8_STAGE(PG8_SB(1, 1), b3 + hstep, voffB); PG8_STAGE(PG8_SA(1, 0), a3, voffA);
            PG8_WAIT_V(8); PG8_WAIT_L(0); PG8_BAR; PG8_MMA(1, 0, At, B0); PG8_MMA(1, 1, At, B1); PG8_BAR; PG8_SCHED;
            } else {
            PG8_LDB(B0, 0, 0); PG8_SCHED; PG8_LDA(At, 0, 0); PG8_STAGE(PG8_SA(1, 1), a1 + hstep, voffA);
            PG8_WAIT_L(8); PG8_BAR; PG8_WAIT_L(0); PG8_MMA(0, 0, At, B0); PG8_BAR; PG8_SCHED;
            PG8_LDB(B1, 0, 1); PG8_STAGE(PG8_SB(0, 0), b2, voffB);
            PG8_BAR; PG8_WAIT_L(0); PG8_MMA(0, 1, At, B1); PG8_BAR;
            PG8_LDA(At, 0, 1); PG8_STAGE(PG8_SA(0, 0), a2, voffA);
            PG8_BAR; PG8_WAIT_L(0); PG8_MMA(1, 0, At, B0); PG8_BAR; PG8_SCHED;
            PG8_STAGE(PG8_SB(0, 1), b2 + hstep, voffB);
            PG8_WAIT_V(6); PG8_BAR; PG8_MMA(1, 1, At, B1); PG8_BAR;
            PG8_LDB(B0, 1, 0); PG8_SCHED; PG8_LDA(At, 1, 0); PG8_STAGE(PG8_SA(0, 1), a2 + hstep, voffA);
            PG8_WAIT_L(8); PG8_BAR; PG8_WAIT_L(0); PG8_MMA(0, 0, At, B0); PG8_BAR; PG8_SCHED;
            PG8_LDB(B1, 1, 1); PG8_STAGE(PG8_SB(1, 0), b3, voffB);
            PG8_BAR; PG8_WAIT_L(0); PG8_MMA(0, 1, At, B1); PG8_BAR;
            PG8_LDA(At, 1, 1); PG8_STAGE(PG8_SA(1, 0), a3, voffA);
            PG8_BAR; PG8_WAIT_L(0); PG8_MMA(1, 0, At, B0); PG8_BAR; PG8_SCHED;
            PG8_STAGE(PG8_SB(1, 1), b3 + hstep, voffB);
            PG8_WAIT_V(6); PG8_BAR; PG8_MMA(1, 1, At, B1); PG8_BAR;
            }
        }
        if constexpr (ALIGN_EPI) { if (wr == 0) PG8_BAR; }
        if constexpr (!Epi::AFTER_DRAIN) { E(acc, cur, wr, wc, fr, fq); S.done(cur); }
        if (!has_next) break;
#pragma unroll
        for (int a = 0; a < 2; ++a)
#pragma unroll
            for (int b = 0; b < 2; ++b)
#pragma unroll
                for (int m = 0; m < 4; ++m)
#pragma unroll
                    for (int n = 0; n < 2; ++n) acc[a][b][m][n] = (f32x4){0.f, 0.f, 0.f, 0.f};
        cur = nxt; cA = nA; cB = nB; ++ui;
        if constexpr (ALIGN_EPI) { if (wr == 1) PG8_BAR; }
    }
    PG8_WAIT_V(0);
    if constexpr (!ALIGN_EPI) { if (wr == 0) PG8_BAR; }
    PG8_BAR;
    if constexpr (Epi::AFTER_DRAIN) { E.fused(acc, cur, wr, wc, fr, fq, lds, wid, lane); S.done(cur); }
#undef PG8_SA
#undef PG8_SB
#undef PG8_STAGE
#undef PG8_LDA
#undef PG8_LDB
#undef PG8_MMA
#undef PG8_WAIT_V
#undef PG8_WAIT_L
#undef PG8_BAR
#undef PG8_SCHED
}
}
namespace att {
typedef unsigned short bf16;
typedef short bf16x8 __attribute__((ext_vector_type(8)));
typedef short s16x4 __attribute__((ext_vector_type(4)));
typedef float f32x16 __attribute__((ext_vector_type(16)));
typedef float f32x4 __attribute__((ext_vector_type(4)));
typedef unsigned u32x4 __attribute__((ext_vector_type(4)));
template <class A, class Bt> struct same_t { static constexpr bool v = false; };
template <class A> struct same_t<A, A> { static constexpr bool v = true; };
constexpr float SCALE = 0.08838834764831845f;
constexpr float THR = 8.f;
constexpr int NW = 8, QBLK = 32, KVBLK = 64, QB = NW * QBLK, D = 128, LDO = 2048;
constexpr int SHM_V = KVBLK * D * 2, SHM_K = KVBLK * D * 2;
constexpr int LDS_BYTES = 2 * SHM_V + 2 * SHM_K + NW * 64 * 4;
#define KSWZ(row, colB) ((row) * 256 + ((colB) ^ (((row) & 7) << 4)))
#define SBAR() __builtin_amdgcn_sched_barrier(0)
__device__ __forceinline__ int v_st(int k, int c) { const int kk = (k & ~0xC) | ((k & 4) << 1) | ((k & 8) >> 1); return ((kk >> 3) * 4 + (c >> 5)) * 512 + ((kk & 7) * 32 + (c & 31)) * 2; }
__device__ __forceinline__ int v_rd_base(int lane) { return ((lane & 3) << 3) | (((lane >> 2) & 3) << 6) | (((lane >> 4) & 1) << 5) | (((lane >> 5) & 1) << 8); }
constexpr int v_rd_off(int d0, int ks, int half) { return d0 * 512 + ks * 4096 + half * 2048; }
__device__ __forceinline__ int crow(int r, int hi) { return (r & 3) + 8 * (r >> 2) + 4 * hi; }
__device__ __forceinline__ unsigned cvtpk(float lo, float hi) {
    unsigned r; asm volatile("v_cvt_pk_bf16_f32 %0, %1, %2" : "=v"(r) : "v"(lo), "v"(hi)); return r;
}
__device__ __forceinline__ bf16x8 pack8(f32x4 a, f32x4 b) {
    u32x4 w = {cvtpk(a[0], a[1]), cvtpk(a[2], a[3]), cvtpk(b[0], b[1]), cvtpk(b[2], b[3])};
    return *reinterpret_cast<bf16x8*>(&w);
}
template <class T> __device__ __forceinline__ bf16x8 load8(const T* p) {
    if constexpr (same_t<T, float>::v) { return pack8(*(const f32x4*)p, *(const f32x4*)(p + 4)); }
    else { return *reinterpret_cast<const bf16x8*>(p); }
}
__device__ __forceinline__ void mask_tile(f32x16& p0, f32x16& p1, int dq, unsigned W) {
    const float NEG = -__builtin_inff();
#pragma unroll
    for (int r = 0; r < 16; ++r) {
        const int c = (r & 3) + 8 * (r >> 2);
        if ((unsigned)(dq - c) >= W) p0[r] = NEG;
        if ((unsigned)(dq - c - 32) >= W) p1[r] = NEG;
    }
}
__device__ __forceinline__ void partialSM(f32x16& p0, f32x16& p1, float& m_reg, float& mn, float& alpha, const bool keep = true) {
    float pmax = p0[0]; for (int r = 1; r < 16; ++r) pmax = fmaxf(pmax, p0[r]); for (int r = 0; r < 16; ++r) pmax = fmaxf(pmax, p1[r]);
    { auto rr = __builtin_amdgcn_permlane32_swap(__float_as_uint(pmax), __float_as_uint(pmax), false, false);
      pmax = fmaxf(__uint_as_float(rr[0]), __uint_as_float(rr[1])); }
    pmax = keep ? pmax : -__builtin_inff();
    constexpr float C2 = 1.4426950408889634f * SCALE;
    if (__builtin_expect(__all((pmax - m_reg) * SCALE <= THR), 1)) { mn = m_reg; alpha = 1.f; }
    else { mn = fmaxf(m_reg, pmax); alpha = __builtin_amdgcn_exp2f((m_reg - mn) * C2); m_reg = mn; }
    const float mnL = keep ? -mn * C2 : -__builtin_inff();
    p0 = p0 * C2 + mnL; p1 = p1 * C2 + mnL;
    for (int r = 0; r < 16; ++r) p0[r] = __builtin_amdgcn_exp2f(p0[r]);
}
__device__ __forceinline__ void finishSM(f32x16& p0, f32x16& p1, float alpha, float& l_reg, bf16x8& pa0, bf16x8& pa1, bf16x8& pa2, bf16x8& pa3) {
    for (int r = 0; r < 16; ++r) p1[r] = __builtin_amdgcn_exp2f(p1[r]);
    float ps;
    { typedef float f32x8_ __attribute__((ext_vector_type(8))); typedef float f32x2_ __attribute__((ext_vector_type(2)));
      f32x8_ s8 = p0.lo + p0.hi; s8 += p1.lo; s8 += p1.hi; const f32x4 s4 = s8.lo + s8.hi; const f32x2_ s2 = s4.lo + s4.hi; ps = s2.x + s2.y; }
    { auto rr = __builtin_amdgcn_permlane32_swap(__float_as_uint(ps), __float_as_uint(ps), false, false);
      ps = __uint_as_float(rr[0]) + __uint_as_float(rr[1]); }
    l_reg = l_reg * alpha + ps;
#define PK4(P, B_, OUT) do { unsigned a0 = cvtpk(P[B_+0], P[B_+1]), a1 = cvtpk(P[B_+2], P[B_+3]);                          \
        unsigned b0 = cvtpk(P[B_+4], P[B_+5]), b1 = cvtpk(P[B_+6], P[B_+7]);                                             \
        auto r0 = __builtin_amdgcn_permlane32_swap(a0, b0, false, false); auto r1 = __builtin_amdgcn_permlane32_swap(a1, b1, false, false); \
        u32x4 w = {r0[0], r1[0], r0[1], r1[1]}; OUT = *reinterpret_cast<bf16x8*>(&w); } while (0)
    PK4(p0, 0, pa0); PK4(p0, 8, pa1); PK4(p1, 0, pa2); PK4(p1, 8, pa3);
#undef PK4
}
template <int KB, bool SK>
__device__ __forceinline__ void qkt(f32x16& p0, f32x16& p1, const char* K_lds, int r32, int hi, const bf16x8* qr, bool act) {
    if (SK && !act) { const float NEG = -__builtin_inff();
#pragma unroll
        for (int r = 0; r < 16; ++r) { p0[r] = NEG; p1[r] = NEG; } return; }
    p0 = f32x16{}; p1 = f32x16{};
    const char* kb[4];
#pragma unroll
    for (int dd = 0; dd < 4; ++dd) kb[dd] = K_lds + KB * SHM_K + KSWZ(r32, (dd * 16 + hi * 8) * 2);
#pragma unroll
    for (int d0 = 0; d0 < 8; ++d0) { const char* a = kb[d0 & 3] + (d0 >> 2) * 128;
        bf16x8 b0 = *reinterpret_cast<const bf16x8*>(a);
        bf16x8 b1 = *reinterpret_cast<const bf16x8*>(a + 32 * 256);
        p0 = __builtin_amdgcn_mfma_f32_32x32x16_bf16(b0, qr[d0], p0, 0, 0, 0);
        p1 = __builtin_amdgcn_mfma_f32_32x32x16_bf16(b1, qr[d0], p1, 0, 0, 0); }
}
template <int VB, bool SK>
__device__ __forceinline__ void pv_tile(f32x16* o, int vb0, bf16x8 pa0, bf16x8 pa1, bf16x8 pa2, bf16x8 pa3, bool act) {
    if (SK && !act) return;
#define TRRD(dst, off) asm volatile("ds_read_b64_tr_b16 %0, %1 offset:%2" : "=&v"(dst) : "v"(vb0), "i"(off) : "memory")
#define PV_LD(S, d0) do { constexpr int b_ = VB * SHM_V + v_rd_off(d0, 0, 0); \
        TRRD(S##l0, b_); TRRD(S##h0, b_ + 2048); TRRD(S##l1, b_ + 4096); TRRD(S##h1, b_ + 6144); TRRD(S##l2, b_ + 8192); TRRD(S##h2, b_ + 10240); TRRD(S##l3, b_ + 12288); TRRD(S##h3, b_ + 14336); } while (0)
#define PV_MM(S, d0) do { \
        o[d0] = __builtin_amdgcn_mfma_f32_32x32x16_bf16(pa0, (bf16x8){S##l0[0], S##l0[1], S##l0[2], S##l0[3], S##h0[0], S##h0[1], S##h0[2], S##h0[3]}, o[d0], 0, 0, 0);   \
        o[d0] = __builtin_amdgcn_mfma_f32_32x32x16_bf16(pa1, (bf16x8){S##l1[0], S##l1[1], S##l1[2], S##l1[3], S##h1[0], S##h1[1], S##h1[2], S##h1[3]}, o[d0], 0, 0, 0);   \
        o[d0] = __builtin_amdgcn_mfma_f32_32x32x16_bf16(pa2, (bf16x8){S##l2[0], S##l2[1], S##l2[2], S##l2[3], S##h2[0], S##h2[1], S##h2[2], S##h2[3]}, o[d0], 0, 0, 0);   \
        o[d0] = __builtin_amdgcn_mfma_f32_32x32x16_bf16(pa3, (bf16x8){S##l3[0], S##l3[1], S##l3[2], S##l3[3], S##h3[0], S##h3[1], S##h3[2], S##h3[3]}, o[d0], 0, 0, 0); } while (0)
    s16x4 Al0, Al1, Al2, Al3, Ah0, Ah1, Ah2, Ah3, Bl0, Bl1, Bl2, Bl3, Bh0, Bh1, Bh2, Bh3;
    PV_LD(A, 0);
    PV_LD(B, 1); asm volatile("s_waitcnt lgkmcnt(8)" ::: "memory"); SBAR(); PV_MM(A, 0); SBAR();
    PV_LD(A, 2); asm volatile("s_waitcnt lgkmcnt(8)" ::: "memory"); SBAR(); PV_MM(B, 1); SBAR();
    PV_LD(B, 3); asm volatile("s_waitcnt lgkmcnt(8)" ::: "memory"); SBAR(); PV_MM(A, 2); SBAR();
    asm volatile("s_waitcnt lgkmcnt(0)" ::: "memory"); SBAR(); PV_MM(B, 3);
#undef PV_LD
#undef PV_MM
#undef TRRD
}
__device__ __forceinline__ void sel_mask(f32x16& p0, f32x16& p1, bool keep) {
    const float NEG = -__builtin_inff();
#pragma unroll
    for (int r = 0; r < 16; ++r) { p0[r] = keep ? p0[r] : NEG; p1[r] = keep ? p1[r] : NEG; }
}
struct BlockRef { int bh; int blk; };
struct Tensors { const bf16* Q; const bf16* K; bf16* O; const float* KS; };
constexpr size_t VOFF = (size_t)64 * 1024 * 1024 / 2;
constexpr int KS_OFF = LDS_BYTES;
#define BR_Q(r) (T.Q + ((size_t)(r).bh * 2048 + (r).blk * 256) * D)
#define BR_K(r) (T.K + (size_t)(r).bh * 2048 * D)
#define BR_V(r) (T.K + VOFF + (size_t)(r).bh * 2048 * D)
#define BR_O(r) (T.O + ((size_t)((r).bh >> 3) * 2048 + (r).blk * 256) * LDO + ((r).bh & 7) * D)
#define BR_KS(r) (T.KS + (size_t)(r).bh * 8 * D)
struct Seam { bf16x8 qr[8]; bf16x8 st_v0, st_v1, st_k0, st_k1; };
#define ROW(p, k0, rr) ((p) + (size_t)((k0) + (rr)) * D + sc)
#define VMW() asm volatile("s_waitcnt vmcnt(0)" ::: "memory")
#define VMWN(n) asm volatile("s_waitcnt vmcnt(%0)" :: "i"(n) : "memory")
#define SLOAD_H(Kp, Vp, k0) do { unsigned lo__ = loff; asm volatile("" : "+v"(lo__)); const char* kb__ = (const char*)(Kp) + (size_t)(k0) * (D * 2); const char* vb__ = (const char*)(Vp) + (size_t)(k0) * (D * 2);   \
                         S.st_v0 = *(const bf16x8*)(vb__ + lo__); S.st_v1 = *(const bf16x8*)(vb__ + lo__ + 32 * D * 2);              \
                         S.st_k0 = *(const bf16x8*)(kb__ + lo__); S.st_k1 = *(const bf16x8*)(kb__ + lo__ + 32 * D * 2); } while (0)
#define SWRITE_HK(bf) do { *(bf16x8*)(K_lds + (bf) * SHM_K + kws) = S.st_k0; *(bf16x8*)(K_lds + (bf) * SHM_K + kws + 32 * 256) = S.st_k1; } while (0)
#define SWRITE_HV(bf) do { *(bf16x8*)(V_lds + (bf) * SHM_V + vst0) = S.st_v0; *(bf16x8*)(V_lds + (bf) * SHM_V + vst1) = S.st_v1; } while (0)
#define SWRITE_H(bf) do { SWRITE_HV(bf); SWRITE_HK(bf); } while (0)
__device__ __forceinline__ void moba_prime(const Tensors& T, const BlockRef& cur, char* lds, Seam& S) {
    const int tid = threadIdx.x, wid = __builtin_amdgcn_readfirstlane(tid >> 6), lane = tid & 63, r32 = lane & 31, hi = lane >> 5;
    const int sr = tid >> 4, sc = (tid & 15) * 8, kws = KSWZ(sr, sc * 2); char* K_lds = lds + 2 * SHM_V; const unsigned loff = (unsigned)(sr * D + sc) * 2u;
#pragma unroll
    for (int d0 = 0; d0 < 8; ++d0) S.qr[d0] = load8<bf16>(BR_Q(cur) + (size_t)(wid * QBLK + r32) * D + d0 * 16 + hi * 8);
    SLOAD_H(BR_K(cur), BR_V(cur), 0);
    if (tid < 256) { const f32x4 v = *(const f32x4*)(BR_KS(cur) + tid * 4); *(f32x4*)(lds + KS_OFF + tid * 16) = v; }
    VMW(); SWRITE_HK(0);
    __syncthreads();
}
__device__ __forceinline__ void moba_block(const Tensors& T, const BlockRef& cur, const BlockRef& nxt, char* lds, Seam& S) {
    const int tid = threadIdx.x, wid = __builtin_amdgcn_readfirstlane(tid >> 6), lane = tid & 63, r32 = lane & 31, hi = lane >> 5;
    const int blk = cur.blk, P0 = blk * QB;
    const int NT = (P0 + QB) / KVBLK;
    const int qlo = P0 + wid * QBLK, qm = qlo + r32 - 4 * hi;
    char* V_lds = lds; char* K_lds = lds + 2 * SHM_V;
    float* ws = (float*)(lds + 2 * SHM_V + 2 * SHM_K) + wid * 64; float* li_l = ws, * al_l = ws + 32;
    float m_reg = -1e30f, l_reg = 0;
    const int sr = tid >> 4, sc = (tid & 15) * 8, vst0 = v_st(sr, sc), vst1 = v_st(32 + sr, sc), kws = KSWZ(sr, sc * 2); const unsigned loff = (unsigned)(sr * D + sc) * 2u;
    const int vb0 = (int)(uintptr_t)V_lds + v_rd_base(lane);
    const bf16* Kh = BR_K(cur); const bf16* Vh = Kh + VOFF;
    unsigned sel = (1u << blk) - 1u;
#ifndef NO_GATE
    if (blk > 3) {
        float qf[64];
#pragma unroll
        for (int d0 = 0; d0 < 8; ++d0)
#pragma unroll
            for (int e = 0; e < 8; ++e) qf[d0 * 8 + e] = __uint_as_float(((unsigned)(unsigned short)S.qr[d0][e]) << 16);
        float b0 = -__builtin_inff(), b1 = b0, b2 = b0; unsigned i0 = 0u, i1 = 0u, i2 = 0u;
#pragma unroll 1
        for (int n = 0; n < blk; ++n) {
            const float* kp = (const float*)(lds + KS_OFF) + n * 128 + hi * 8;
            float g = 0.f;
#pragma unroll
            for (int d0 = 0; d0 < 8; ++d0) { const f32x4 a = *(const f32x4*)(kp + d0 * 16), b = *(const f32x4*)(kp + d0 * 16 + 4);
                g += (qf[d0 * 8 + 0] * a[0] + qf[d0 * 8 + 1] * a[1]) + (qf[d0 * 8 + 2] * a[2] + qf[d0 * 8 + 3] * a[3]) + (qf[d0 * 8 + 4] * b[0] + qf[d0 * 8 + 5] * b[1]) + (qf[d0 * 8 + 6] * b[2] + qf[d0 * 8 + 7] * b[3]); }
            { auto rr = __builtin_amdgcn_permlane32_swap(__float_as_uint(g), __float_as_uint(g), false, false); g = __uint_as_float(rr[0]) + __uint_as_float(rr[1]); }
            const unsigned bit = 1u << n;
            const bool c0 = g > b0, c1 = g > b1, c2 = g > b2;
            b2 = c1 ? b1 : (c2 ? g : b2); i2 = c1 ? i1 : (c2 ? bit : i2);
            b1 = c0 ? b0 : (c1 ? g : b1); i1 = c0 ? i0 : (c1 ? bit : i1);
            b0 = c0 ? g : b0;             i0 = c0 ? bit : i0;
        }
        sel = i0 | i1 | i2;
    }
#endif
    f32x16 o[4] = {};
#define RESC(a) do { if (__any((a) < 1.f)) { if (hi == 0) al_l[r32] = (a); asm volatile("s_waitcnt lgkmcnt(0)" ::: "memory");              \
                     for (int d_ = 0; d_ < 4; ++d_) for (int r = 0; r < 16; ++r) o[d_][r] *= al_l[crow(r, hi)]; } } while (0)
#define KBASE(t) ((t) * KVBLK)
#define MASKT(P0_, P1_, t) do { const int kb_ = KBASE(t); \
        if (kb_ >= P0) { if (kb_ + KVBLK - 1 > qlo) mask_tile(P0_, P1_, qm - kb_, 0x7fffffffu); } } while (0)
#define KEEPT(t) ((KBASE(t) >= P0) || (((sel >> ((t) >> 2)) & 1u) != 0u))
    constexpr int NQL = 8;
    constexpr bool SK = false;
#define SEAM_K0() do { VMWN(NQL); SWRITE_HK(0); SBAR(); } while (0)
    f32x16 pA0, pA1, pB0, pB1; float mnA, mnB, alA, alB; bf16x8 pa0, pa1, pa2, pa3;
    SWRITE_HV(0); SBAR();
    SLOAD_H(Kh, Vh, KBASE(1));
    SBAR(); qkt<0, SK>(pA0, pA1, K_lds, r32, hi, S.qr, true);
    MASKT(pA0, pA1, 0); partialSM(pA0, pA1, m_reg, mnA, alA, KEEPT(0));
    VMW(); SWRITE_H(1);
    __syncthreads();
#define HALF_STEP(PX0, PX1, mnX, alX, PY0, PY1, alY, t, KB, VB, SB) do {                                                      \
        SBAR(); if ((t) + 1 < NT) { SLOAD_H(Kh, Vh, KBASE((t) + 1)); SBAR(); }                                                \
        qkt<KB, SK>(PX0, PX1, K_lds, r32, hi, S.qr, true);                                                                    \
        finishSM(PY0, PY1, alY, l_reg, pa0, pa1, pa2, pa3); SBAR();                                                           \
        pv_tile<VB, SK>(o, vb0, pa0, pa1, pa2, pa3, true); MASKT(PX0, PX1, (t)); partialSM(PX0, PX1, m_reg, mnX, alX, KEEPT(t));        \
        __syncthreads();                                                                                                      \
        if ((t) + 1 < NT) { VMW(); SWRITE_H(SB); }                                                                            \
        RESC(alX); __syncthreads(); } while (0)
    for (int t = 1; t + 1 < NT; t += 2) {
        HALF_STEP(pB0, pB1, mnB, alB, pA0, pA1, alA, t, 1, 0, 0);
        HALF_STEP(pA0, pA1, mnA, alA, pB0, pB1, alB, t + 1, 0, 1, 1);
    }
    { SBAR(); qkt<1, SK>(pB0, pB1, K_lds, r32, hi, S.qr, true); SBAR(); }
    SLOAD_H(BR_K(nxt), BR_V(nxt), 0); SBAR();
    { unsigned qo__ = (unsigned)((wid * QBLK + r32) * D + hi * 8) * 2u; asm volatile("" : "+v"(qo__)); const char* qb__ = (const char*)BR_Q(nxt) + qo__;
#pragma unroll
      for (int d0 = 0; d0 < 8; ++d0) S.qr[d0] = *(const bf16x8*)(qb__ + d0 * 32); }
    SBAR();
    finishSM(pA0, pA1, alA, l_reg, pa0, pa1, pa2, pa3); SBAR();
    pv_tile<0, SK>(o, vb0, pa0, pa1, pa2, pa3, true);
    { MASKT(pB0, pB1, NT - 1); partialSM(pB0, pB1, m_reg, mnB, alB, KEEPT(NT - 1)); __syncthreads(); RESC(alB);
      finishSM(pB0, pB1, alB, l_reg, pa0, pa1, pa2, pa3); SBAR(); pv_tile<1, SK>(o, vb0, pa0, pa1, pa2, pa3, true); }
    SBAR(); SEAM_K0();
    if (hi == 0) li_l[r32] = l_reg; asm volatile("s_waitcnt lgkmcnt(0)" ::: "memory");
    float rli[16];
#pragma unroll
    for (int r = 0; r < 16; ++r) rli[r] = __builtin_amdgcn_rcpf(li_l[crow(r, hi)]);
    char* Ow = (char*)(BR_O(cur) + (size_t)(wid * QBLK) * LDO);
    unsigned oo__ = (unsigned)(4 * hi * LDO + r32) * 2u; asm volatile("" : "+v"(oo__));
#pragma unroll
    for (int r = 0; r < 16; ++r) { const int orow0 = (r & 3) + 8 * (r >> 2);
#pragma unroll
        for (int d0 = 0; d0 < 4; ++d0) { const float v = o[d0][r] * rli[r];
            const float vn = __shfl_xor(v, 1);
            if ((r32 & 1) == 0) *(unsigned*)(Ow + (size_t)(orow0 * LDO + d0 * 32) * 2 + oo__) = cvtpk(v, vn); } }
    if (tid < 256) { unsigned ko__ = (unsigned)tid * 16u; asm volatile("" : "+v"(ko__)); const f32x4 v = *(const f32x4*)((const char*)BR_KS(nxt) + ko__); *(f32x4*)(lds + KS_OFF + tid * 16) = v; }
    __syncthreads();
#undef RESC
#undef KBASE
#undef MASKT
#undef KEEPT
#undef SEAM_K0
#undef HALF_STEP
}
#undef ROW
#undef BR_Q
#undef BR_K
#undef BR_V
#undef BR_O
#undef BR_KS
#undef VMW
#undef VMWN
#undef SLOAD_H
#undef SWRITE_HK
#undef SWRITE_HV
#undef SWRITE_H
#undef SBAR
#undef KSWZ
}

#define LAS __attribute__((address_space(3)))
typedef unsigned short bf16_t;
typedef float f32x4 __attribute__((ext_vector_type(4)));
typedef float f32x2 __attribute__((ext_vector_type(2)));
typedef unsigned u32x4 __attribute__((ext_vector_type(4)));
typedef unsigned u32x2 __attribute__((ext_vector_type(2)));

constexpr int NTHREADS = 512, NWAVES = 8;
constexpr int RING_BYTES = 131072, LDS_BYTES = RING_BYTES + 4096;
constexpr size_t MiB = 1u << 20;
constexpr size_t WS_MOD = 0, WS_ROPEC = 1 * MiB, WS_ROPES = WS_ROPEC + 512 * 1024, WS_KSUM = 2 * MiB;
constexpr size_t WS_CTL = 3 * MiB;
constexpr size_t WS_WIN = 4 * MiB, WS_WOUT = 24 * MiB, WS_WGU = 32 * MiB, WS_WDN = 76 * MiB;
constexpr size_t WS_U = 98 * MiB, WS_Q = 226 * MiB, WS_K = 290 * MiB, WS_V = 354 * MiB, WS_GLU = 418 * MiB, WS_AC = 482 * MiB;
constexpr size_t WS_ACT = 226 * MiB;
constexpr size_t WS_H1 = 610 * MiB;
constexpr size_t WS_H2 = WS_U;
constexpr size_t WS_END = 738 * MiB;
static_assert(WS_WIN + (size_t)INW * DM * 2 <= WS_WOUT && WS_WOUT + (size_t)DM * DM * 2 <= WS_WGU && WS_WGU + (size_t)2 * DFF * DM * 2 <= WS_WDN && WS_WDN + (size_t)DM * DFF * 2 <= WS_U, "weights map");
static_assert(WS_U + (size_t)MROWS * DM * 2 <= WS_Q && WS_ACT + (size_t)MROWS * DFF * 2 <= WS_END && WS_AC + (size_t)MROWS * DM * 2 <= WS_END, "activation map");

struct Args {
    const float *x, *c, *w_ada, *b_ada, *g_mix, *w_in, *conv_w, *conv_b, *ln_g, *ln_b, *w_out, *g_ffn, *w_gate, *w_up, *w_down, *g_final;
    float* out; unsigned char* ws; int ph_lo, ph_hi;
};

__device__ const double INVREV[64] = {
1.59154943091895346e-01, 1.37822502603982849e-01, 1.19349370211248862e-01, 1.03352296618434064e-01,
8.94994016088910133e-02, 7.75032887553740585e-02, 6.71150830052272551e-02, 5.81192674418762462e-02,
5.03292121044870353e-02, 4.35833021053073297e-02, 3.77415847174197711e-02, 3.26828658723569976e-02,
2.83021958306233987e-02, 2.45086918620698521e-02, 2.12236527647776604e-02, 1.83789261056796667e-02,
1.59154943091895339e-02, 1.37822502603982839e-02, 1.19349370211248862e-02, 1.03352296618434061e-02,
8.94994016088910237e-03, 7.75032887553740550e-03, 6.71150830052272534e-03, 5.81192674418762410e-03,
5.03292121044870370e-03, 4.35833021053073314e-03, 3.77415847174197719e-03, 3.26828658723569932e-03,
2.83021958306233987e-03, 2.45086918620698521e-03, 2.12236527647776622e-03, 1.83789261056796667e-03,
1.59154943091895356e-03, 1.37822502603982878e-03, 1.19349370211248849e-03, 1.03352296618434048e-03,
8.94994016088910237e-04, 7.75032887553740507e-04, 6.71150830052272599e-04, 5.81192674418762388e-04,
5.03292121044870326e-04, 4.35833021053073292e-04, 3.77415847174197741e-04, 3.26828658723569922e-04,
2.83021958306233954e-04, 2.45086918620698543e-04, 2.12236527647776605e-04, 1.83789261056796662e-04,
1.59154943091895351e-04, 1.37822502603982856e-04, 1.19349370211248862e-04, 1.03352296618434061e-04,
8.94994016088910182e-05, 7.75032887553740561e-05, 6.71150830052272545e-05, 5.81192674418762388e-05,
5.03292121044870354e-05, 4.35833021053073225e-05, 3.77415847174197768e-05, 3.26828658723569989e-05,
2.83021958306233961e-05, 2.45086918620698523e-05, 2.12236527647776592e-05, 1.83789261056796682e-05
};

__device__ __forceinline__ unsigned f2bf(float f) { unsigned u = __builtin_bit_cast(unsigned, f); return (u + 0x7fffu + ((u >> 16) & 1u)) >> 16; }
__device__ __forceinline__ unsigned pk2(float lo, float hi) { return f2bf(lo) | (f2bf(hi) << 16); }
__device__ __forceinline__ float wave_sum(float v) {
#pragma unroll
    for (int o = 1; o < 64; o <<= 1) v += __shfl_xor(v, o);
    return v;
}
#define LDS_WAIT() asm volatile("s_waitcnt lgkmcnt(0)" ::: "memory")

__device__ __forceinline__ void transpose_item(const float* __restrict__ W, int N, int col0, int k0, bf16_t* __restrict__ WT, int K, int n0, LAS unsigned* scr, int lane) {
    {
        float v[64];
        const float* wp = W + (size_t)k0 * N + col0 + lane;
#pragma unroll
        for (int i = 0; i < 64; ++i) v[i] = __builtin_nontemporal_load(wp + (size_t)i * N);
#pragma unroll
        for (int i = 0; i < 32; ++i) scr[lane * 36 + i] = pg8::cvt_pk_bf16(v[2 * i], v[2 * i + 1]);
    }
    LDS_WAIT(); asm volatile("" ::: "memory");
#pragma unroll
    for (int j = 0; j < 8; ++j) { const int n = j * 8 + (lane >> 3), ch = lane & 7;
        const u32x4 o = *(const LAS u32x4*)(scr + n * 36 + ch * 4);
        *(u32x4*)(WT + (size_t)(n0 + n) * K + k0 + ch * 8) = o; }
    LDS_WAIT(); asm volatile("" ::: "memory");
}

__device__ __forceinline__ void phase0(const Args& a, LAS unsigned char* lds, int G) {
    const int tid = threadIdx.x, lane = tid & 63, wave = __builtin_amdgcn_readfirstlane(tid >> 6), bx = blockIdx.x;
    float* MOD = (float*)(a.ws + WS_MOD); float* RC = (float*)(a.ws + WS_ROPEC); float* RS = (float*)(a.ws + WS_ROPES); float* KSUM = (float*)(a.ws + WS_KSUM);
    if (bx == 0) { unsigned* ctl = (unsigned*)(a.ws + WS_CTL); for (int i = tid; i < 4096; i += NTHREADS) __hip_atomic_store(ctl + i, 0u, __ATOMIC_RELAXED, __HIP_MEMORY_SCOPE_AGENT); }
    {
        const int gt = bx * NTHREADS + tid, NT = G * NTHREADS;
        for (int i = gt; i < BATCH * NH * 8 * HD; i += NT) KSUM[i] = 0.f;
        for (int i = gt; i < SEQ * 64; i += NT) { const int t = i >> 6, j = i & 63; double rev = (double)t * INVREV[j]; rev -= __builtin_floor(rev); const float fr = (float)rev;
            RC[i] = __builtin_amdgcn_cosf(fr); RS[i] = __builtin_amdgcn_sinf(fr); }
    }
    for (int s = ((G % 8 == 0) ? (bx % 8) * (G / 8) + bx / 8 : bx); s < 256; s += G) {
        const int n0 = s * 48, kbeg = wave * 256, lb = lane & 15, kq = lane >> 4;
        float csr[64];
        { const float* cp = a.c + (size_t)lb * DM + kbeg + kq;
#pragma unroll
          for (int j = 0; j < 64; ++j) { const float cv = cp[4 * j]; csr[j] = cv * __builtin_amdgcn_rcpf(1.0f + __expf(-cv)); } }
        f32x4 acc0 = (f32x4){0.f, 0.f, 0.f, 0.f}, acc1 = acc0, acc2 = acc0;
        const float* wp = a.w_ada + (size_t)(kbeg + kq) * NMODC + n0 + lb;
#pragma unroll
        for (int j = 0; j < 64; ++j) {
            const float w0 = wp[(size_t)(4 * j) * NMODC], w1 = wp[(size_t)(4 * j) * NMODC + 16], w2 = wp[(size_t)(4 * j) * NMODC + 32];
            acc0 = __builtin_amdgcn_mfma_f32_16x16x4f32(csr[j], w0, acc0, 0, 0, 0);
            acc1 = __builtin_amdgcn_mfma_f32_16x16x4f32(csr[j], w1, acc1, 0, 0, 0);
            acc2 = __builtin_amdgcn_mfma_f32_16x16x4f32(csr[j], w2, acc2, 0, 0, 0);
        }
        LAS float* red = (LAS float*)lds;
#pragma unroll
        for (int e = 0; e < 4; ++e) { LAS float* rp = red + (wave * 16 + 4 * kq + e) * 48 + lb; rp[0] = acc0[e]; rp[16] = acc1[e]; rp[32] = acc2[e]; }
        __syncthreads();
        for (int i = tid; i < 16 * 48; i += NTHREADS) { const int b = i / 48, l = i - b * 48; float sum = a.b_ada[n0 + l];
#pragma unroll
            for (int w = 0; w < 8; ++w) sum += red[(w * 16 + b) * 48 + l];
            MOD[(size_t)b * NMODC + n0 + l] = sum; }
        __syncthreads();
    }
}

constexpr int I_IN = 32 * 80, I_OUT = 32 * 32, I_GU = 32 * 176, I_DN = 88 * 32;
__device__ __forceinline__ void weight_copies(const Args& a, LAS unsigned char* lds, int G, const int it_lo, const int it_hi) {
    const int tid = threadIdx.x, lane = tid & 63, wave = __builtin_amdgcn_readfirstlane(tid >> 6), bx = blockIdx.x;
    {
        LAS unsigned* scr = (LAS unsigned*)lds + wave * 2304;
        bf16_t* WIN = (bf16_t*)(a.ws + WS_WIN); bf16_t* WOUT = (bf16_t*)(a.ws + WS_WOUT); bf16_t* WGU = (bf16_t*)(a.ws + WS_WGU); bf16_t* WDN = (bf16_t*)(a.ws + WS_WDN);
        const int gw = bx * NWAVES + wave, NGW = G * NWAVES;
        for (int it = it_lo + gw; it < it_hi; it += NGW) {
            int r = it;
            if (r < I_IN) { const int kb = r / 80, nb = r - kb * 80, n0 = nb * 64; int col0;
                if (n0 < 2048) col0 = (n0 & ~0xC0) | ((n0 & 0x40) << 1) | ((n0 & 0x80) >> 1);
                else if (n0 < 3072) col0 = n0;
                else { const int j = n0 - 3072; col0 = 3072 + ((j >> 7) & 1) * 1024 + (j >> 8) * 128 + (j & 127); }
                transpose_item(a.w_in, INW, col0, kb * 64, WIN, DM, n0, scr, lane); continue; }
            r -= I_IN;
            if (r < I_OUT) { const int kb = r >> 5, nb = r & 31; transpose_item(a.w_out, DM, nb * 64, kb * 64, WOUT, DM, nb * 64, scr, lane); continue; }
            r -= I_OUT;
            if (r < I_GU) { const int kb = r / 176, nb = r - kb * 176, n0 = nb * 64; const int col0 = (n0 >> 8) * 128 + (n0 & 127);
                transpose_item(((n0 >> 7) & 1) ? a.w_up : a.w_gate, DFF, col0, kb * 64, WGU, DM, n0, scr, lane); continue; }
            r -= I_GU;
            { const int kb = r >> 5, nb = r & 31; transpose_item(a.w_down, DM, nb * 64, kb * 64, WDN, DFF, nb * 64, scr, lane); }
        }
    }
}

template <int MODE, bool SRC_BF16>
__device__ __forceinline__ void rows_phase(const void* src, const float* __restrict__ g, const float* __restrict__ sc, const float* __restrict__ sh, bf16_t* __restrict__ dst, float* __restrict__ dstf, int G) {
    const int tid = threadIdx.x, lane = tid & 63, wave = __builtin_amdgcn_readfirstlane(tid >> 6);
    const int vb_ = (G % 8 == 0) ? (int)(blockIdx.x % 8) * (G / 8) + (int)(blockIdx.x / 8) : (int)blockIdx.x;
    const int gw = vb_ * NWAVES + wave, NGW = G * NWAVES;
    for (int it = gw; it < MROWS / 16; it += NGW) {
        const int row0 = it * 16, b = row0 >> 11;
        f32x4 pa[4][2], pb[4][2];
#pragma unroll
        for (int j = 0; j < 4; ++j)
#pragma unroll
            for (int h = 0; h < 2; ++h) { const int col = 8 * lane + 512 * j + 4 * h; pa[j][h] = *(const f32x4*)(g + col);
                if (MODE == 0) { pa[j][h] = pa[j][h] * (*(const f32x4*)(sc + (size_t)b * NMODC + col) + 1.0f); pb[j][h] = *(const f32x4*)(sh + (size_t)b * NMODC + col); } }
#pragma unroll 2
        for (int r = 0; r < 16; ++r) {
            const size_t roff = (size_t)(row0 + r) * DM + 8 * lane;
            f32x4 v[4][2]; float ss = 0.f;
#pragma unroll
            for (int j = 0; j < 4; ++j) {
                if (SRC_BF16) { const u32x4 w = __builtin_nontemporal_load((const u32x4*)((const bf16_t*)src + roff + 512 * j));
                    v[j][0] = (f32x4){__uint_as_float(w.x << 16), __uint_as_float(w.x & 0xffff0000u), __uint_as_float(w.y << 16), __uint_as_float(w.y & 0xffff0000u)};
                    v[j][1] = (f32x4){__uint_as_float(w.z << 16), __uint_as_float(w.z & 0xffff0000u), __uint_as_float(w.w << 16), __uint_as_float(w.w & 0xffff0000u)}; }
                else { v[j][0] = __builtin_nontemporal_load((const f32x4*)((const float*)src + roff + 512 * j)); v[j][1] = __builtin_nontemporal_load((const f32x4*)((const float*)src + roff + 512 * j + 4)); }
#pragma unroll
                for (int h = 0; h < 2; ++h) ss += (v[j][h][0] * v[j][h][0] + v[j][h][1] * v[j][h][1]) + (v[j][h][2] * v[j][h][2] + v[j][h][3] * v[j][h][3]); }
            const float rstd = 1.0f / sqrtf(wave_sum(ss) * (1.0f / DM) + EPS);
            if (MODE == 0) {
#pragma unroll
                for (int j = 0; j < 4; ++j) { const f32x4 o0 = v[j][0] * rstd * pa[j][0] + pb[j][0], o1 = v[j][1] * rstd * pa[j][1] + pb[j][1];
                    *(u32x4*)(dst + roff + 512 * j) = pg8::pack8(o0, o1); } }
            else {
#pragma unroll
                for (int j = 0; j < 4; ++j) { *(f32x4*)(dstf + roff + 512 * j) = v[j][0] * rstd * pa[j][0]; *(f32x4*)(dstf + roff + 512 * j + 4) = v[j][1] * rstd * pa[j][1]; } }
        }
    }
}

#ifndef P3_REP
#define P3_REP 1
#endif
__device__ __forceinline__ void conv_phase(const Args& a, LAS unsigned char* lds, int G) {
    const int tid = threadIdx.x, lane = tid & 63, wave = __builtin_amdgcn_readfirstlane(tid >> 6);
    const bf16_t* GLU = (const bf16_t*)(a.ws + WS_GLU); bf16_t* AC = (bf16_t*)(a.ws + WS_AC);
    LAS float* red = (LAS float*)lds;
    LAS float* stat = red + 128;
    f32x2 w[CK];
#pragma unroll
    for (int j = 0; j < CK; ++j) w[j] = *(const f32x2*)(a.conv_w + j * CW + 2 * tid);
    const f32x2 bias = *(const f32x2*)(a.conv_b + 2 * tid), lg = *(const f32x2*)(a.ln_g + 2 * tid), lb = *(const f32x2*)(a.ln_b + 2 * tid);
    for (int ctr = blockIdx.x; ctr < P3_REP * (MROWS / 32); ctr += G) { const int c0_ = ctr % (MROWS / 32);
        const int ct = (G == 256) ? ((c0_ & 7) * 128 + ((c0_ >> 3) & 31) + 32 * (c0_ >> 8)) : c0_;
        const int row0 = ct * 32, t0 = row0 & (SEQ - 1);
        const unsigned* up = (const unsigned*)GLU + (size_t)row0 * (CW / 2) + tid;
        f32x2 x[38];
#pragma unroll
        for (int j = 0; j < 30; ++j) { unsigned p = 0u; if (t0 != 0) p = up[(j - 30) * (CW / 2)]; x[j] = (f32x2){__uint_as_float(p << 16), __uint_as_float(p & 0xffff0000u)}; }
        unsigned nx[8];
#pragma unroll
        for (int o = 0; o < 8; ++o) nx[o] = up[o * (CW / 2)];
        for (int it = 0; it < 4; ++it) {
#pragma unroll
            for (int o = 0; o < 8; ++o) { const unsigned p = nx[o]; x[30 + o] = (f32x2){__uint_as_float(p << 16), __uint_as_float(p & 0xffff0000u)}; }
            if (it < 3) {
#pragma unroll
                for (int o = 0; o < 8; ++o) nx[o] = up[((it + 1) * 8 + o) * (CW / 2)]; }
            f32x2 y[8];
#pragma unroll
            for (int o = 0; o < 8; ++o) y[o] = bias;
#pragma unroll
            for (int j = 0; j < CK; ++j)
#pragma unroll
                for (int o = 0; o < 8; ++o) y[o] += w[j] * x[o + j];
            float sv[16];
#pragma unroll
            for (int o = 0; o < 8; ++o) { sv[2 * o] = y[o][0] + y[o][1]; sv[2 * o + 1] = y[o][0] * y[o][0] + y[o][1] * y[o][1]; }
#pragma unroll
            for (int i = 0; i < 16; ++i) sv[i] = wave_sum(sv[i]);
            if (lane == 0) {
#pragma unroll
                for (int i = 0; i < 16; ++i) red[wave * 16 + i] = sv[i]; }
            __syncthreads();
            if (tid < 8) { float s = 0.f, q = 0.f;
#pragma unroll
                for (int wv = 0; wv < 8; ++wv) { s += red[wv * 16 + 2 * tid]; q += red[wv * 16 + 2 * tid + 1]; }
                const float mean = s * (1.0f / CW), var = q * (1.0f / CW) - mean * mean;
                stat[2 * tid] = mean; stat[2 * tid + 1] = 1.0f / sqrtf(fmaxf(var, 0.f) + EPS); }
            __syncthreads();
#pragma unroll
            for (int o = 0; o < 8; ++o) { const float mean = stat[2 * o], rstd = stat[2 * o + 1];
                const f32x2 yn = (y[o] - mean) * rstd * lg + lb;
                const float o0 = yn[0] * pg8::sigmoid_fast(yn[0]), o1 = yn[1] * pg8::sigmoid_fast(yn[1]);
                *((unsigned*)(AC + (size_t)(row0 + it * 8 + o) * DM + CW) + tid) = pk2(o0, o1); }
#pragma unroll
            for (int j = 0; j < 30; ++j) x[j] = x[j + 8];
        }
    }
}

__device__ __forceinline__ att::BlockRef attn_ref(int vcu, int G, int s) {
    const int Lv = (G == 256) ? ((vcu >> 5) * 64 + (vcu & 31) + 32 * (s >> 1)) : (vcu + (s >> 1) * G), y = Lv & 3;
    att::BlockRef r; r.bh = Lv >> 2; r.blk = (s & 1) ? 7 - y : y;
    return r;
}
__device__ __forceinline__ void attn_phase(const Args& a, char* lds, int vcu, int G) {
    static_assert(WS_V - WS_K == 64 * MiB, "att::VOFF");
    int nitems = 0; for (int i = 0; vcu + i * G < BATCH * NH * 4; ++i) ++nitems;
    const int ns = 2 * nitems; if (ns == 0) return;
    att::Tensors T; T.Q = (const bf16_t*)(a.ws + WS_Q); T.K = (const bf16_t*)(a.ws + WS_K); T.O = (bf16_t*)(a.ws + WS_AC); T.KS = (const float*)(a.ws + WS_KSUM);
    att::Seam S; att::BlockRef cur = attn_ref(vcu, G, 0);
    att::moba_prime(T, cur, lds, S);
#ifndef P3_REP
#define P3_REP 1
#endif
    for (int s = 0; s < ns * P3_REP; ++s) {
        const att::BlockRef nxt = (s + 1 < ns * P3_REP) ? attn_ref(vcu, G, (s + 1) % ns) : cur;
        att::moba_block(T, cur, nxt, lds, S);
        cur = nxt;
    }
}

#define RLX_AGENT __ATOMIC_RELAXED, __HIP_MEMORY_SCOPE_AGENT
#define XB_TMO      128
#define XB_XCNT(j)  (256  + 64 * (j))
#define XB_XSUB(j)  (1280 + 64 * (j))
#define XB_XGEN(j)  (2304 + 64 * (j))
#define XB_TOP      3328
#define XB_TOPGEN   3392
#define XCD_BAR_WORDS 3456
#define XB_SPIN_CAP (1u << 18)

__device__ __forceinline__ unsigned xb_ld(unsigned* p)              { return __hip_atomic_load(p, __ATOMIC_RELAXED, __HIP_MEMORY_SCOPE_AGENT); }
__device__ __forceinline__ unsigned xb_add(unsigned* p, unsigned v) { return __hip_atomic_fetch_add(p, v, __ATOMIC_RELAXED, __HIP_MEMORY_SCOPE_AGENT); }
__device__ __forceinline__ unsigned xb_xcc_id() { return (unsigned)__builtin_amdgcn_s_getreg((3 << 11) | 20) & 0xFu; }
#define XB_SPIN(cond, bar) do { unsigned _sp = 0; while (cond) { __builtin_amdgcn_s_sleep(1); \
    if ((++_sp & 255u) == 0u) { if (xb_ld(&(bar)[XB_TMO])) break; if (_sp > XB_SPIN_CAP) { atomicAdd(&(bar)[XB_TMO], 1u); break; } } } } while (0)

struct XcdBarrier {
    unsigned* bar; unsigned x;
    volatile LAS unsigned* st;
};

__device__ __forceinline__ XcdBarrier xcd_barrier_post(unsigned* bar, volatile LAS unsigned* st) {
    XcdBarrier b; b.bar = bar; b.x = xb_xcc_id(); b.st = st;
    if (threadIdx.x == 0) (void)xb_add(&bar[XB_XCNT(b.x)], 1u);
    return b;
}
__device__ __forceinline__ void xcd_barrier_complete(unsigned* bar, unsigned x, unsigned& nloc, unsigned& nx) {
    const unsigned G = gridDim.x * gridDim.y * gridDim.z;
    unsigned sum, cnt, mine, sp = 0u;
    for (;;) {
        sum = 0u; cnt = 0u; mine = 0u;
#pragma unroll
        for (unsigned j = 0; j < 16; ++j) { const unsigned c = xb_ld(&bar[XB_XCNT(j)]); sum += c; cnt += (c > 0u) ? 1u : 0u; mine = (j == x) ? c : mine; }
        if (sum == G) break;
        __builtin_amdgcn_s_sleep(1);
        if ((++sp & 255u) == 0u) { if (xb_ld(&bar[XB_TMO])) break; if (sp > XB_SPIN_CAP) { atomicAdd(&bar[XB_TMO], 1u); break; } }
    }
    nloc = mine > 0u ? mine : 1u; nx = cnt > 0u ? cnt : 1u;
}

__device__ __forceinline__ void xcd_barrier(const XcdBarrier& b) {
    asm volatile("s_waitcnt vmcnt(0)" ::: "memory");
    __syncthreads();
    if (threadIdx.x == 0) {
        unsigned* bar = b.bar;
        __builtin_amdgcn_s_waitcnt(0);
        unsigned nloc = b.st[0], nx = b.st[1];
        if (nloc == 0u) { xcd_barrier_complete(bar, b.x, nloc, nx); b.st[0] = nloc; b.st[1] = nx; }
        const unsigned old = xb_add(&bar[XB_XSUB(b.x)], 1u);
        const unsigned gen = old / nloc;
        if (old + 1u == (gen + 1u) * nloc) {
            __builtin_amdgcn_fence(__ATOMIC_RELEASE, "agent");
            asm volatile("s_waitcnt vmcnt(0)" ::: "memory");
            const unsigned og = xb_add(&bar[XB_TOP], 1u);
            const unsigned tg = og / nx;
            if (og + 1u == (tg + 1u) * nx) xb_add(&bar[XB_TOPGEN], 1u);
            else XB_SPIN(xb_ld(&bar[XB_TOPGEN]) == tg, bar);
            __builtin_amdgcn_fence(__ATOMIC_ACQUIRE, "agent");
            xb_add(&bar[XB_XGEN(b.x)], 1u);
            asm volatile("s_waitcnt vmcnt(0)" ::: "memory");
        } else {
            XB_SPIN(xb_ld(&bar[XB_XGEN(b.x)]) == gen, bar);
            __builtin_amdgcn_fence(__ATOMIC_ACQUIRE, "agent");
            asm volatile("s_waitcnt vmcnt(0)" ::: "memory");
        }
    }
    __syncthreads();
}

typedef const __attribute__((address_space(4))) Args* ArgsP;
__device__ __forceinline__ Args load_args() {
#if defined(__HIP_DEVICE_COMPILE__)
    ArgsP p = (ArgsP)__builtin_amdgcn_kernarg_segment_ptr(); asm volatile("" : "+s"(p)); return *p;
#else
    return Args{};
#endif
}
__global__ void __launch_bounds__(NTHREADS, 2) mega_fwd(Args a_unused) {
    extern __shared__ __attribute__((aligned(16))) unsigned char lds_raw[];
    LAS unsigned char* lds = (LAS unsigned char*)lds_raw;
    const int G = gridDim.x, bx = blockIdx.x;
    const int vcu = (G % 8 == 0) ? (bx % 8) * (G / 8) + bx / 8 : bx;
    cg::grid_group grid = cg::this_grid();
    volatile LAS unsigned* bst = (volatile LAS unsigned*)(lds + RING_BYTES);
    if (threadIdx.x < 4) bst[threadIdx.x] = 0u;
    __syncthreads();
    XcdBarrier bar; bar.bar = nullptr; bar.x = 0; bar.st = bst;
    const int lo = a_unused.ph_lo, hi = a_unused.ph_hi;
#ifndef PH_MASK
#define PH_MASK 0x1ff
#endif
#ifndef REP_MASK
#define REP_MASK 0
#endif
#define IN(k) (((PH_MASK >> (k)) & 1) && lo <= (k) && (k) < hi)
#define REP(k) for (int rep_ = 0; rep_ < 1 + ((REP_MASK >> (k)) & 1); ++rep_)
#define SEAM(k) do { if (IN(k) && IN((k) + 1)) { if ((k) == 0) { grid.sync(); bar = xcd_barrier_post((unsigned*)(load_args().ws + WS_CTL), bst); } else xcd_barrier(bar); } } while (0)
    if (IN(0)) REP(0) { const Args a = load_args(); phase0(a, lds, G); } SEAM(0);
    if (IN(1)) REP(1) { const Args a = load_args(); float* MOD = (float*)(a.ws + WS_MOD); rows_phase<0, false>(a.x, a.g_mix, MOD + DM, MOD, (bf16_t*)(a.ws + WS_U), nullptr, G); weight_copies(a, lds, G, 0, I_IN + I_OUT); } SEAM(1);
    if (IN(2)) REP(2) { const Args a = load_args();
        pg8::Gemm g{(const bf16_t*)(a.ws + WS_U), (const bf16_t*)(a.ws + WS_WIN), MROWS, INW, DM}; pg8::StaticOrder S; S.init(MROWS, INW, G, bx, 4);
        pg8::EpiIn E{(bf16_t*)(a.ws + WS_Q), (bf16_t*)(a.ws + WS_K), (bf16_t*)(a.ws + WS_V), (bf16_t*)(a.ws + WS_GLU), (float*)(a.ws + WS_KSUM), (const float*)(a.ws + WS_ROPEC), (const float*)(a.ws + WS_ROPES)};
        pg8::gemm_phase<pg8::EpiIn, pg8::StaticOrder, true, true>(lds, g, S, E);
    } SEAM(2);
    if (IN(3)) REP(3) {
#ifndef NO_ATTN
        { const Args a = load_args(); attn_phase(a, (char*)lds_raw, vcu, G); } __syncthreads();
#endif
#ifndef NO_CONV
        { const Args a = load_args(); conv_phase(a, lds, G); } __syncthreads();
#endif
    } SEAM(3);
    if (IN(4)) REP(4) { const Args a = load_args();
        pg8::Gemm g{(const bf16_t*)(a.ws + WS_AC), (const bf16_t*)(a.ws + WS_WOUT), MROWS, DM, DM}; pg8::StaticOrder S; S.init(MROWS, DM, G, bx, 4);
        pg8::EpiRes<false> E{a.x, (bf16_t*)(a.ws + WS_H1), (const float*)(a.ws + WS_MOD) + 2 * DM};
        pg8::gemm_phase<pg8::EpiRes<false>, pg8::StaticOrder, true, true>(lds, g, S, E);
    } SEAM(4);
    if (IN(5)) REP(5) { const Args a = load_args(); float* MOD = (float*)(a.ws + WS_MOD); weight_copies(a, lds, G, I_IN + I_OUT, I_IN + I_OUT + I_GU + I_DN); rows_phase<0, true>(a.ws + WS_H1, a.g_ffn, MOD + 4 * DM, MOD + 3 * DM, (bf16_t*)(a.ws + WS_U), nullptr, G); } SEAM(5);
    if (IN(6)) REP(6) { const Args a = load_args();
        pg8::Gemm g{(const bf16_t*)(a.ws + WS_U), (const bf16_t*)(a.ws + WS_WGU), MROWS, 2 * DFF, DM}; pg8::StaticOrder S; S.init(MROWS, 2 * DFF, G, bx, 4);
        pg8::EpiGU E{(bf16_t*)(a.ws + WS_ACT)};
        pg8::gemm_phase<pg8::EpiGU, pg8::StaticOrder, true, true>(lds, g, S, E);
    } SEAM(6);
    if (IN(7)) REP(7) { const Args a = load_args();
        pg8::Gemm g{(const bf16_t*)(a.ws + WS_ACT), (const bf16_t*)(a.ws + WS_WDN), MROWS, DM, DFF}; pg8::StaticOrder S; S.init(MROWS, DM, G, bx, 4); S.rev = 1;
        pg8::EpiRes<true> E{a.ws + WS_H1, (bf16_t*)(a.ws + WS_H2), (const float*)(a.ws + WS_MOD) + 5 * DM};
        pg8::gemm_phase<pg8::EpiRes<true>, pg8::StaticOrder, true, true>(lds, g, S, E);
    } SEAM(7);
    if (IN(8)) REP(8) { const Args a = load_args(); rows_phase<1, true>(a.ws + WS_H2, a.g_final, nullptr, nullptr, nullptr, a.out, G); }
#undef IN
#undef SEAM
}

#ifndef MK_N_LAUNCHES
#define MK_N_LAUNCHES 1
#endif
extern "C" void kernel_launch(void* const* d_in, const int* in_sizes, int n_in, void* d_out, int out_size, void* d_ws, size_t ws_size, hipStream_t stream) {
    static int grid = 0;
    if (grid == 0) {
        if (n_in != 16 || in_sizes[0] != MROWS * DM || out_size != MROWS * DM || ws_size < WS_END) {
            fprintf(stderr, "kernel_launch: unexpected shapes (n_in %d, in0 %d, out %d, ws %zu); nothing launched\n", n_in, n_in > 0 ? in_sizes[0] : -1, out_size, ws_size); grid = -1; return; }
        int dev = 0, cus = 0, per_cu = 0;
        (void)hipGetDevice(&dev); (void)hipDeviceGetAttribute(&cus, hipDeviceAttributeMultiprocessorCount, dev);
        if (hipFuncSetAttribute((const void*)mega_fwd, hipFuncAttributeMaxDynamicSharedMemorySize, LDS_BYTES) != hipSuccess) { fprintf(stderr, "kernel_launch: hipFuncSetAttribute failed\n"); grid = -1; return; }
        if (hipOccupancyMaxActiveBlocksPerMultiprocessor(&per_cu, (const void*)mega_fwd, NTHREADS, LDS_BYTES) != hipSuccess || per_cu < 1) { fprintf(stderr, "kernel_launch: occupancy query gave %d\n", per_cu); per_cu = 1; }
        (void)hipGetLastError();
        if (cus <= 0) cus = 256;
        grid = cus * per_cu;
        fprintf(stderr, "kernel_launch: grid %d (cus %d x %d)\n", grid, cus, per_cu);
    }
    if (grid < 0) return;
    Args a{};
    a.x = (const float*)d_in[0]; a.c = (const float*)d_in[1]; a.w_ada = (const float*)d_in[2]; a.b_ada = (const float*)d_in[3]; a.g_mix = (const float*)d_in[4];
    a.w_in = (const float*)d_in[5]; a.conv_w = (const float*)d_in[6]; a.conv_b = (const float*)d_in[7]; a.ln_g = (const float*)d_in[8]; a.ln_b = (const float*)d_in[9];
    a.w_out = (const float*)d_in[10]; a.g_ffn = (const float*)d_in[11]; a.w_gate = (const float*)d_in[12]; a.w_up = (const float*)d_in[13]; a.w_down = (const float*)d_in[14]; a.g_final = (const float*)d_in[15];
    a.out = (float*)d_out; a.ws = (unsigned char*)d_ws;
    constexpr int NPH = 9;
    if (MK_N_LAUNCHES == 1) {
        a.ph_lo = 0; a.ph_hi = NPH;
        void* args[] = {&a};
        const hipError_t e = hipLaunchCooperativeKernel((const void*)mega_fwd, dim3(grid), dim3(NTHREADS), args, LDS_BYTES, stream);
        if (e != hipSuccess) fprintf(stderr, "kernel_launch: cooperative launch failed: %s (grid %d)\n", hipGetErrorString(e), grid);
    } else {
        for (int p = 0; p < NPH; ++p) { a.ph_lo = p; a.ph_hi = p + 1; hipLaunchKernelGGL(mega_fwd, dim3(grid), dim3(NTHREADS), LDS_BYTES, stream, a); }
    }
}
```
